# Optimizing an MI355X kernel written in HIP

```python
import math
import jax, jax.numpy as jnp
from jax import lax
import numpy as np

D_MODEL = 4096
BATCH = 1
SEQ = 8192
DEPTH = 1
DEC_BATCH = 8
DEC_SEQ = 2048
PAST_LEN = 128

HEAD_DIM = 128
N_HEADS_TOTAL = D_MODEL // HEAD_DIM
NA_HEADS = N_HEADS_TOTAL // 2
SWA_Q_HEADS = N_HEADS_TOTAL - NA_HEADS
SWA_KV_HEADS = max(1, SWA_Q_HEADS // 4)
NA_WIDTH = NA_HEADS * HEAD_DIM
SWA_Q_WIDTH = SWA_Q_HEADS * HEAD_DIM
SWA_KV_WIDTH = SWA_KV_HEADS * HEAD_DIM
MIX_WIDTH = NA_WIDTH + SWA_Q_WIDTH
IN_WIDTH = 3 * NA_WIDTH + SWA_Q_WIDTH + 2 * SWA_KV_WIDTH
IN_SPLITS = (NA_WIDTH, 2 * NA_WIDTH, 3 * NA_WIDTH, 3 * NA_WIDTH + SWA_Q_WIDTH,
             3 * NA_WIDTH + SWA_Q_WIDTH + SWA_KV_WIDTH)
D_FF = 4 * D_MODEL
GRID_W = 64
NA_ROWS = 8
NA_COLS = 16
SWA_WINDOW = 128
SWA_BLOCK = 128
T5_BUCKETS = 32
T5_MAX_DIST = 128
N_META = 16
NORM_EPS = 1e-6
NEG_INF = -1e30

kernel_name = "hymba_na_swa_encoder"


def rms_norm(x, gain):
    xf = x.astype(jnp.float32)
    y = xf * lax.rsqrt(jnp.mean(xf * xf, axis=-1, keepdims=True) + NORM_EPS)
    return (y * gain.astype(jnp.float32)).astype(x.dtype)


def t5_bucket(rel):
    nb = T5_BUCKETS // 2
    max_exact = nb // 2
    ret = np.where(rel > 0, nb, 0)
    n = np.abs(rel)
    large = max_exact + (np.log(np.maximum(n, 1) / max_exact)
                         / math.log(T5_MAX_DIST / max_exact) * (nb - max_exact)).astype(np.int64)
    large = np.minimum(large, nb - 1)
    return ret + np.where(n < max_exact, n, large)


def neighborhood_attention(q, k, v, rpb, with_meta_queries):
    batch, L, H, Dh = q.shape
    T = L - N_META
    rows = T // GRID_W
    kr_ = min(NA_ROWS, rows)
    scale = Dh ** -0.5
    qm, km, vm = q[:, :N_META], k[:, :N_META], v[:, :N_META]
    r = np.arange(rows)
    rs = np.clip(r - kr_ // 2, 0, rows - kr_)
    row_idx = rs[:, None] + np.arange(kr_)[None, :]
    dr = row_idx - r[:, None]
    c = np.arange(GRID_W)
    cs = np.clip(c - NA_COLS // 2, 0, GRID_W - NA_COLS)
    dc = c[None, :] - c[:, None]
    col_in = (c[None, :] >= cs[:, None]) & (c[None, :] < cs[:, None] + NA_COLS)
    bias = rpb[:, dr[:, None, :, None] + (NA_ROWS - 1),
               np.clip(dc, -(NA_COLS - 1), NA_COLS - 1)[None, :, None, :] + (NA_COLS - 1)]
    qg = q[:, N_META:].reshape(batch, rows, GRID_W, H, Dh)
    kg = k[:, N_META:].reshape(batch, rows, GRID_W, H, Dh)[:, row_idx]
    vg = v[:, N_META:].reshape(batch, rows, GRID_W, H, Dh)[:, row_idx]
    s = jnp.einsum('brqhd,brikhd->bhrqik', qg, kg,
                   preferred_element_type=jnp.float32) * scale + bias[None].astype(jnp.float32)
    s = jnp.where(col_in[:, None, :], s, NEG_INF).reshape(batch, H, rows, GRID_W, kr_ * GRID_W)
    s_m = jnp.einsum('brqhd,bmhd->bhrqm', qg, km, preferred_element_type=jnp.float32) * scale
    p = jax.nn.softmax(jnp.concatenate([s_m, s], axis=-1), axis=-1).astype(v.dtype)
    p_m = p[..., :N_META]
    p_w = p[..., N_META:].reshape(batch, H, rows, GRID_W, kr_, GRID_W)
    o = (jnp.einsum('bhrqm,bmhd->brqhd', p_m, vm, preferred_element_type=jnp.float32)
         + jnp.einsum('bhrqik,brikhd->brqhd', p_w, vg, preferred_element_type=jnp.float32))
    o_real = o.reshape(batch, T, H * Dh).astype(q.dtype)
    o_meta = None
    if with_meta_queries:
        sm = jnp.einsum('bqhd,bmhd->bhqm', qm, km, preferred_element_type=jnp.float32) * scale
        pm = jax.nn.softmax(sm, axis=-1).astype(v.dtype)
        o_meta = jnp.einsum('bhqm,bmhd->bqhd', pm, vm).reshape(batch, N_META, H * Dh)
    return o_meta, o_real


def window_attention(q, k, v, t5_bias, sink, with_meta_queries):
    batch, L, Hq, Dh = q.shape
    Hkv = k.shape[2]
    G = Hq // Hkv
    T = L - N_META
    blk = SWA_BLOCK
    nb = T // blk
    scale = Dh ** -0.5
    qm, km, vm = q[:, :N_META], k[:, :N_META], v[:, :N_META]
    kr, vr = k[:, N_META:], v[:, N_META:]
    qb = q[:, N_META:].reshape(batch, nb, blk, Hkv, G, Dh)
    pad = ((0, 0), (blk, blk), (0, 0), (0, 0))
    kp, vp = jnp.pad(kr, pad), jnp.pad(vr, pad)

    def band(a):
        return jnp.concatenate([a[:, o * blk:o * blk + T].reshape(batch, nb, blk, Hkv, Dh)
                                for o in range(3)], axis=2)

    kw, vw = band(kp), band(vp)
    qq = np.arange(blk)
    jj = np.arange(3 * blk)
    rel_w = (jj[None, :] - blk) - qq[:, None]
    key_t = np.arange(nb)[:, None] * blk - blk + jj[None, :]
    ok_w = (np.abs(rel_w) <= SWA_WINDOW)[None] & ((key_t >= 0) & (key_t < T))[:, None, :]
    bias_w = t5_bias[t5_bucket(rel_w)].transpose(2, 0, 1).reshape(Hkv, G, blk, 3 * blk)
    rel_m = np.arange(N_META)[None, :] - (N_META + np.arange(T))[:, None]
    bias_m = t5_bias[t5_bucket(rel_m)].reshape(nb, blk, N_META, Hkv, G).transpose(0, 3, 4, 1, 2)
    s_w = jnp.einsum('bnqhgd,bnkhd->bnhgqk', qb, kw,
                     preferred_element_type=jnp.float32) * scale + bias_w.astype(jnp.float32)
    s_w = jnp.where(ok_w[:, None, None], s_w, NEG_INF)
    s_m = jnp.einsum('bnqhgd,bmhd->bnhgqm', qb, km,
                     preferred_element_type=jnp.float32) * scale + bias_m.astype(jnp.float32)
    sink_col = jnp.broadcast_to(sink.astype(jnp.float32).reshape(Hkv, G, 1, 1),
                                s_w.shape[:-1] + (1,))
    p = jax.nn.softmax(jnp.concatenate([s_m, s_w, sink_col], axis=-1), axis=-1).astype(v.dtype)
    o = (jnp.einsum('bnhgqm,bmhd->bnqhgd', p[..., :N_META], vm, preferred_element_type=jnp.float32)
         + jnp.einsum('bnhgqk,bnkhd->bnqhgd', p[..., N_META:N_META + 3 * blk], vw,
                      preferred_element_type=jnp.float32))
    o_real = o.reshape(batch, T, Hq * Dh).astype(q.dtype)
    o_meta = None
    if with_meta_queries:
        kq = jnp.concatenate([km, kr[:, :blk]], axis=1)
        vq = jnp.concatenate([vm, vr[:, :blk]], axis=1)
        kpos = np.arange(N_META + blk)
        rel_q = kpos[None, :] - np.arange(N_META)[:, None]
        ok_q = (kpos[None, :] < N_META) | (np.abs(rel_q) <= SWA_WINDOW)
        bias_q = t5_bias[t5_bucket(rel_q)].transpose(2, 0, 1).reshape(Hkv, G, N_META, N_META + blk)
        qmg = qm.reshape(batch, N_META, Hkv, G, Dh)
        sq = jnp.einsum('bqhgd,bkhd->bhgqk', qmg, kq,
                        preferred_element_type=jnp.float32) * scale + bias_q.astype(jnp.float32)
        sq = jnp.where(ok_q, sq, NEG_INF)
        sink_q = jnp.broadcast_to(sink.astype(jnp.float32).reshape(Hkv, G, 1, 1), sq.shape[:-1] + (1,))
        pq = jax.nn.softmax(jnp.concatenate([sq, sink_q], axis=-1), axis=-1).astype(v.dtype)
        o_meta = jnp.einsum('bhgqk,bkhd->bqhgd', pq[..., :-1], vq).reshape(batch, N_META, Hq * Dh)
    return o_meta, o_real


def sq_relu_mlp(h, gain, w_up, w_down):
    u = rms_norm(h, gain) @ w_up
    return jnp.square(jax.nn.relu(u)) @ w_down


def encoder_layer(m, x, t5_bias, g_attn, w_in, qn_na, kn_na, rpb, qn_sw, kn_sw, sink,
                  w_out, g_mlp, w_up, w_down, update_meta):
    batch = x.shape[0]
    h = jnp.concatenate([m, x], axis=1)
    L = h.shape[1]
    proj = rms_norm(h, g_attn) @ w_in
    q_na, k_na, v_na, q_sw, k_sw, v_sw = jnp.split(proj, IN_SPLITS, axis=-1)

    def heads(a, n):
        return a.reshape(batch, L, n, HEAD_DIM)

    q_na = rms_norm(heads(q_na, NA_HEADS), qn_na)
    k_na = rms_norm(heads(k_na, NA_HEADS), kn_na)
    q_sw = rms_norm(heads(q_sw, SWA_Q_HEADS), qn_sw)
    k_sw = rms_norm(heads(k_sw, SWA_KV_HEADS), kn_sw)
    na_m, na_r = neighborhood_attention(q_na, k_na, heads(v_na, NA_HEADS), rpb, update_meta)
    sw_m, sw_r = window_attention(q_sw, k_sw, heads(v_sw, SWA_KV_HEADS), t5_bias, sink, update_meta)
    x = x + jnp.concatenate([na_r, sw_r], axis=-1) @ w_out
    x = x + sq_relu_mlp(x, g_mlp, w_up, w_down)
    if update_meta:
        m = m + jnp.concatenate([na_m, sw_m], axis=-1) @ w_out
        m = m + sq_relu_mlp(m, g_mlp, w_up, w_down)
    return m, x


def encoder_trunk(x, meta_tokens, t5_bias, norm_attn, w_in, q_norm_na, k_norm_na, na_rpb,
                  q_norm_swa, k_norm_swa, swa_sink, w_out, norm_mlp, w_up, w_down):
    batch = x.shape[0]
    m = jnp.broadcast_to(meta_tokens.astype(x.dtype)[None], (batch, N_META, D_MODEL))
    for layer in range(DEPTH):
        m, x = encoder_layer(m, x, t5_bias, norm_attn[layer], w_in[layer], q_norm_na[layer],
                             k_norm_na[layer], na_rpb[layer], q_norm_swa[layer], k_norm_swa[layer],
                             swa_sink[layer], w_out[layer], norm_mlp[layer], w_up[layer],
                             w_down[layer], update_meta=layer < DEPTH - 1)
    return x


def setup_inputs(seed: int = 0) -> dict:
    key = jax.random.key(seed)
    ks = jax.random.split(key, 16)
    f32 = jnp.float32
    nrm = jax.random.normal
    return {
        "x_prompt": nrm(ks[0], (BATCH, SEQ, D_MODEL), f32),
        "x_sample": nrm(ks[1], (DEC_BATCH, DEC_SEQ, D_MODEL), f32),
        "meta_tokens": nrm(ks[2], (N_META, D_MODEL), f32),
        "t5_bias": 0.3 * nrm(ks[3], (T5_BUCKETS, SWA_Q_HEADS), f32),
        "norm_attn": 1.0 + 0.02 * nrm(ks[4], (DEPTH, D_MODEL), f32),
        "w_in": nrm(ks[5], (DEPTH, D_MODEL, IN_WIDTH), f32) * D_MODEL ** -0.5,
        "q_norm_na": 1.0 + 0.02 * nrm(ks[6], (DEPTH, HEAD_DIM), f32),
        "k_norm_na": 1.0 + 0.02 * nrm(ks[7], (DEPTH, HEAD_DIM), f32),
        "na_rpb": 0.3 * nrm(ks[8], (DEPTH, NA_HEADS, 2 * NA_ROWS - 1, 2 * NA_COLS - 1), f32),
        "q_norm_swa": 1.0 + 0.02 * nrm(ks[9], (DEPTH, HEAD_DIM), f32),
        "k_norm_swa": 1.0 + 0.02 * nrm(ks[10], (DEPTH, HEAD_DIM), f32),
        "swa_sink": 0.5 * nrm(ks[11], (DEPTH, SWA_Q_HEADS), f32),
        "w_out": nrm(ks[12], (DEPTH, MIX_WIDTH, D_MODEL), f32) * MIX_WIDTH ** -0.5,
        "norm_mlp": 1.0 + 0.02 * nrm(ks[13], (DEPTH, D_MODEL), f32),
        "w_up": nrm(ks[14], (DEPTH, D_MODEL, D_FF), f32) * D_MODEL ** -0.5,
        "w_down": nrm(ks[15], (DEPTH, D_FF, D_MODEL), f32) * D_FF ** -0.5,
    }


def reference(x_prompt, x_sample, meta_tokens, t5_bias, norm_attn, w_in, q_norm_na, k_norm_na,
              na_rpb, q_norm_swa, k_norm_swa, swa_sink, w_out, norm_mlp, w_up, w_down):
    y_prompt = encoder_trunk(x_prompt, meta_tokens, t5_bias, norm_attn, w_in, q_norm_na, k_norm_na,
                             na_rpb, q_norm_swa, k_norm_swa, swa_sink, w_out, norm_mlp, w_up, w_down)
    y_sample = encoder_trunk(x_sample, meta_tokens, t5_bias, norm_attn, w_in, q_norm_na, k_norm_na,
                             na_rpb, q_norm_swa, k_norm_swa, swa_sink, w_out, norm_mlp, w_up, w_down)
    return (y_prompt, y_sample)
```

```cpp
#include <hip/hip_runtime.h>
#include <cstdio>
#include <cstdint>
namespace pg8 {
#define PG8_LAS __attribute__((address_space(3)))
typedef unsigned short bf16_t;
typedef short bf16x8 __attribute__((ext_vector_type(8)));
typedef float f32x4 __attribute__((ext_vector_type(4)));
typedef unsigned u32x4 __attribute__((ext_vector_type(4)));
constexpr int BM = 256, BK = 64, HALF = 128, HTB = HALF * BK * 2  , STAGE_BYTES = 8 * HTB, NXCD = 8, WGM = 8;

__host__ __device__ __forceinline__ int lds_byte(int r, int c) { const int st = (r >> 4) * 2 + (c >> 5), rr = r & 15, cc = c & 31, ob = rr * 64 + cc * 2; return st * 1024 + (ob ^ (((ob >> 9) & 1) << 5)); }
__host__ __device__ __forceinline__ void stage_rc(int b, int& R, int& C) { const int st = b / 1024, sb = b % 1024, swz = sb ^ (((sb >> 9) & 1) << 5); R = (st >> 1) * 16 + swz / 64; C = (st & 1) * 32 + (swz % 64) / 2; }
__host__ __device__ __forceinline__ int perm32(int rho) { const int n = rho >> 4, i = rho & 15; return 8 * (i >> 2) + 4 * n + (i & 3); }

struct Unit { int pm, pn; };
struct Gemm { const bf16_t* A; const bf16_t* Bt; int M, N, K; };

struct StaticOrder {
    int nM, nN, nwg, G, c;
    __host__ __device__ void init(int M, int N, int G_, int c_) { nM = M / BM; nN = N / BM; nwg = nM * nN; G = G_; c = c_; }
    __host__ __device__ bool next(int i, Unit& u) const {
        const long L = (long)i * G + c; if (L >= nwg) return false;
        int wgid = (int)L; { const int q = nwg / NXCD, r = nwg % NXCD, xcd = wgid % NXCD, off = wgid / NXCD; wgid = (xcd < r ? xcd * (q + 1) : r * (q + 1) + (xcd - r) * q) + off; }
        const int nig = WGM * nN, gid = wgid / nig, fm = gid * WGM, gsz = (nM - fm) < WGM ? (nM - fm) : WGM;
        u.pm = fm + ((wgid % nig) % gsz); u.pn = (wgid % nig) / gsz; return true;
    }
    __device__ __forceinline__ void a_ready(const Unit&) const {}
    __device__ __forceinline__ void done(const Unit&) const {}
};


__device__ __forceinline__ unsigned cvt_pk_bf16(float lo, float hi) { unsigned r; asm volatile("v_cvt_pk_bf16_f32 %0, %1, %2" : "=v"(r) : "v"(lo), "v"(hi)); return r; }

template <int ACT> struct EpiBf16 {
    static constexpr bool PERM = true, AFTER_DRAIN = false;
    bf16_t* O; int ldc; int row_off;
    __device__ __forceinline__ void operator()(const f32x4 (&acc)[2][2][4][2], const Unit& u, int wr, int wc, int fr, int fq) const {
        const int row0 = row_off + u.pm * BM + wr * 64 + fr; const int col0 = u.pn * BM + wc * 32 + 8 * fq;
#pragma unroll
        for (int ai = 0; ai < 2; ++ai)
#pragma unroll
            for (int m = 0; m < 4; ++m) { bf16_t* rowp = O + (size_t)(row0 + ai * HALF + m * 16) * ldc + col0;
#pragma unroll
                for (int bj = 0; bj < 2; ++bj) { f32x4 v0 = acc[ai][bj][m][0], v1 = acc[ai][bj][m][1];
                    if (ACT == 1) {
#pragma unroll
                        for (int j = 0; j < 4; ++j) { const float a = fmaxf(v0[j], 0.f), b = fmaxf(v1[j], 0.f); v0[j] = a * a; v1[j] = b * b; } }
                    u32x4 w; w.x = cvt_pk_bf16(v0[0], v0[1]); w.y = cvt_pk_bf16(v0[2], v0[3]); w.z = cvt_pk_bf16(v1[0], v1[1]); w.w = cvt_pk_bf16(v1[2], v1[3]);
                    *(u32x4*)(rowp + bj * HALF) = w; } }
    }
};
struct EpiResF32 {
    static constexpr bool PERM = false, AFTER_DRAIN = false;
    const float* base0; const float* base1; int split; float* out; int ldc;
    __device__ __forceinline__ void operator()(const f32x4 (&acc)[2][2][4][2], const Unit& u, int wr, int wc, int fr, int fq) const {
        const int r0 = wr * 64 + fr, col0 = u.pn * BM + wc * 32 + 4 * fq;
        const float* bp = (u.pm < split) ? base0 + (size_t)u.pm * BM * ldc : base1 + (size_t)(u.pm - split) * BM * ldc;
        float* op = out + (size_t)u.pm * BM * ldc;
#pragma unroll
        for (int ai = 0; ai < 2; ++ai)
#pragma unroll
            for (int m = 0; m < 4; ++m) { const size_t off = (size_t)(r0 + ai * HALF + m * 16) * ldc + col0;
                f32x4 bs[2][2];
#pragma unroll
                for (int bj = 0; bj < 2; ++bj)
#pragma unroll
                    for (int n = 0; n < 2; ++n) bs[bj][n] = *(const f32x4*)(bp + off + bj * HALF + n * 16);
#pragma unroll
                for (int bj = 0; bj < 2; ++bj)
#pragma unroll
                    for (int n = 0; n < 2; ++n) *(f32x4*)(op + off + bj * HALF + n * 16) = bs[bj][n] + acc[ai][bj][m][n];
                if (m & 1) asm volatile("" ::: "memory"); }
    }
};

template <class Epi, class Sched, bool ALIGN_EPI = false, bool SP2 = false>
__device__ __forceinline__ void gemm_phase(PG8_LAS unsigned char* lds, const Gemm g, const Sched& S, const Epi& E) {
    int tid_ = threadIdx.x; asm volatile("" : "+v"(tid_));
    const int tid = tid_, wid = __builtin_amdgcn_readfirstlane(tid >> 6), lane = tid & 63, wr = wid >> 2, wc = wid & 3, fr = lane & 15, fq = lane >> 4;
    const int K = g.K, nt = K / BK;
    unsigned voffA[2], voffB[2];
#pragma unroll
    for (int i = 0; i < 2; ++i) { int R, C; stage_rc(tid * 16 + i * 8192, R, C); const int Rb = Epi::PERM ? ((R & ~31) + perm32(R & 31)) : R;
        voffA[i] = (unsigned)(R * K + C) * 2u; voffB[i] = (unsigned)(Rb * K + C) * 2u; }
    const size_t kstep = (size_t)(BK * 2);
    const size_t hstep = (size_t)HALF * K * 2;
    const size_t tstep = 2 * hstep;
    const unsigned ldsw = (unsigned)wid * 1024u;
    const int aoff = lds_byte(wr * 64 + fr, fq * 8), boff = lds_byte(wc * 32 + fr, fq * 8);
#define PG8_SA(b, h) (((b) * 2 + (h)) * HTB)
#define PG8_SB(b, h) ((4 + (b) * 2 + (h)) * HTB)
#define PG8_STAGE(bufoff, gbase, voff) do { _Pragma("unroll") for (int _i = 0; _i < 2; ++_i) \
        __builtin_amdgcn_global_load_lds((const unsigned*)((const char*)(gbase) + (voff)[_i]), (PG8_LAS unsigned*)(lds + (bufoff) + ldsw + _i * 8192), 16, 0, 0); } while (0)
#define PG8_LDA(dst, b, h) do { _Pragma("unroll") for (int m = 0; m < 4; ++m) _Pragma("unroll") for (int k = 0; k < 2; ++k) dst[m][k] = *(const PG8_LAS bf16x8*)(lds + PG8_SA(b, h) + aoff + m * 2048 + k * 1024); } while (0)
#define PG8_LDB(dst, b, h) do { _Pragma("unroll") for (int n = 0; n < 2; ++n) _Pragma("unroll") for (int k = 0; k < 2; ++k) dst[n][k] = *(const PG8_LAS bf16x8*)(lds + PG8_SB(b, h) + boff + n * 2048 + k * 1024); } while (0)
#define PG8_MMA(ai, bj, At, Bt) do { __builtin_amdgcn_s_setprio(1); _Pragma("unroll") for (int m = 0; m < 4; ++m) _Pragma("unroll") for (int n = 0; n < 2; ++n) _Pragma("unroll") for (int k = 0; k < 2; ++k) \
        acc[ai][bj][m][n] = __builtin_amdgcn_mfma_f32_16x16x32_bf16(Bt[n][k], At[m][k], acc[ai][bj][m][n], 0, 0, 0); __builtin_amdgcn_s_setprio(0); } while (0)
#define PG8_WAIT_V(n) asm volatile("s_waitcnt vmcnt(" #n ")" ::: "memory")
#define PG8_WAIT_L(n) asm volatile("s_waitcnt lgkmcnt(" #n ")" ::: "memory")
#define PG8_BAR __builtin_amdgcn_s_barrier()
#define PG8_SCHED __builtin_amdgcn_sched_barrier(0)
    Unit cur, nxt; int ui = 0;
    if (!S.next(0, cur)) return;
    f32x4 acc[2][2][4][2];
#pragma unroll
    for (int a = 0; a < 2; ++a)
#pragma unroll
        for (int b = 0; b < 2; ++b)
#pragma unroll
            for (int m = 0; m < 4; ++m)
#pragma unroll
                for (int n = 0; n < 2; ++n) acc[a][b][m][n] = (f32x4){0.f, 0.f, 0.f, 0.f};
    bf16x8 At[4][2], B0[2][2], B1[2][2];
    const char* cA = (const char*)g.A + (size_t)cur.pm * tstep; const char* cB = (const char*)g.Bt + (size_t)cur.pn * tstep;
    S.a_ready(cur);
    if constexpr (SP2) {
        PG8_STAGE(PG8_SB(0, 0), cB, voffB); PG8_STAGE(PG8_SB(0, 1), cB + hstep, voffB); PG8_STAGE(PG8_SA(0, 0), cA, voffA); PG8_STAGE(PG8_SA(0, 1), cA + hstep, voffA);
        if (wr == 1) PG8_BAR;
        PG8_WAIT_V(2); PG8_BAR;
        PG8_STAGE(PG8_SB(1, 0), cB + kstep, voffB); PG8_STAGE(PG8_SA(1, 0), cA + kstep, voffA); PG8_STAGE(PG8_SB(1, 1), cB + hstep + kstep, voffB);
        PG8_WAIT_V(6); PG8_BAR;
    } else {
        PG8_STAGE(PG8_SB(0, 0), cB, voffB); PG8_STAGE(PG8_SA(0, 0), cA, voffA); PG8_STAGE(PG8_SB(0, 1), cB + hstep, voffB); PG8_STAGE(PG8_SA(0, 1), cA + hstep, voffA);
        if (wr == 1) PG8_BAR;
        PG8_WAIT_V(4); PG8_BAR;
        PG8_STAGE(PG8_SB(1, 0), cB + kstep, voffB); PG8_STAGE(PG8_SA(1, 0), cA + kstep, voffA); PG8_STAGE(PG8_SB(1, 1), cB + hstep + kstep, voffB);
        PG8_WAIT_V(6); PG8_BAR;
    }
    for (;;) {
        const bool has_next = S.next(ui + 1, nxt);
        const char* nA = has_next ? (const char*)g.A + (size_t)nxt.pm * tstep : cA; const char* nB = has_next ? (const char*)g.Bt + (size_t)nxt.pn * tstep : cB;
        for (int t = 0; t < nt; t += 2) {
            const bool last = (t == nt - 2);
            const char* a1 = cA + (size_t)(t + 1) * kstep;
            const char* a2 = last ? nA : cA + (size_t)(t + 2) * kstep; const char* b2 = last ? nB : cB + (size_t)(t + 2) * kstep;
            const char* a3 = a2 + kstep; const char* b3 = b2 + kstep;
            if (last && has_next) S.a_ready(nxt);
            if constexpr (SP2) {
            PG8_LDB(B0, 0, 0); PG8_LDB(B1, 0, 1); PG8_SCHED; PG8_LDA(At, 0, 0); PG8_STAGE(PG8_SA(1, 1), a1 + hstep, voffA);
            PG8_WAIT_V(8); PG8_WAIT_L(0); PG8_BAR; PG8_MMA(0, 0, At, B0); PG8_MMA(0, 1, At, B1); PG8_BAR; PG8_SCHED;
            PG8_LDA(At, 0, 1); PG8_STAGE(PG8_SB(0, 0), b2, voffB); PG8_STAGE(PG8_SB(0, 1), b2 + hstep, voffB); PG8_STAGE(PG8_SA(0, 0), a2, voffA);
            PG8_WAIT_V(8); PG8_WAIT_L(0); PG8_BAR; PG8_MMA(1, 0, At, B0); PG8_MMA(1, 1, At, B1); PG8_BAR; PG8_SCHED;
            PG8_LDB(B0, 1, 0); PG8_LDB(B1, 1, 1); PG8_SCHED; PG8_LDA(At, 1, 0); PG8_STAGE(PG8_SA(0, 1), a2 + hstep, voffA);
            PG8_WAIT_V(8); PG8_WAIT_L(0); PG8_BAR; PG8_MMA(0, 0, At, B0); PG8_MMA(0, 1, At, B1); PG8_BAR; PG8_SCHED;
            PG8_LDA(At, 1, 1); PG8_STAGE(PG8_SB(1, 0), b3, voffB); PG8_STAGE(PG8_SB(1, 1), b3 + hstep, voffB); PG8_STAGE(PG8_SA(1, 0), a3, voffA);
            PG8_WAIT_V(8); PG8_WAIT_L(0); PG8_BAR; PG8_MMA(1, 0, At, B0); PG8_MMA(1, 1, At, B1); PG8_BAR; PG8_SCHED;
            } else {
            PG8_LDB(B0, 0, 0); PG8_SCHED; PG8_LDA(At, 0, 0); PG8_STAGE(PG8_SA(1, 1), a1 + hstep, voffA);
            PG8_WAIT_L(8); PG8_BAR; PG8_WAIT_L(0); PG8_MMA(0, 0, At, B0); PG8_BAR; PG8_SCHED;
            PG8_LDB(B1, 0, 1); PG8_STAGE(PG8_SB(0, 0), b2, voffB);
            PG8_BAR; PG8_WAIT_L(0); PG8_MMA(0, 1, At, B1); PG8_BAR;
            PG8_LDA(At, 0, 1); PG8_STAGE(PG8_SA(0, 0), a2, voffA);
            PG8_BAR; PG8_WAIT_L(0); PG8_MMA(1, 0, At, B0); PG8_BAR; PG8_SCHED;
            PG8_STAGE(PG8_SB(0, 1), b2 + hstep, voffB);
            PG8_WAIT_V(6); PG8_BAR; PG8_MMA(1, 1, At, B1); PG8_BAR;
            PG8_LDB(B0, 1, 0); PG8_SCHED; PG8_LDA(At, 1, 0); PG8_STAGE(PG8_SA(0, 1), a2 + hstep, voffA);
            PG8_WAIT_L(8); PG8_BAR; PG8_WAIT_L(0); PG8_MMA(0, 0, At, B0); PG8_BAR; PG8_SCHED;
            PG8_LDB(B1, 1, 1); PG8_STAGE(PG8_SB(1, 0), b3, voffB);
            PG8_BAR; PG8_WAIT_L(0); PG8_MMA(0, 1, At, B1); PG8_BAR;
            PG8_LDA(At, 1, 1); PG8_STAGE(PG8_SA(1, 0), a3, voffA);
            PG8_BAR; PG8_WAIT_L(0); PG8_MMA(1, 0, At, B0); PG8_BAR; PG8_SCHED;
            PG8_STAGE(PG8_SB(1, 1), b3 + hstep, voffB);
            PG8_WAIT_V(6); PG8_BAR; PG8_MMA(1, 1, At, B1); PG8_BAR;
            }
        }
        if constexpr (ALIGN_EPI) { if (wr == 0) PG8_BAR; }
        if constexpr (!Epi::AFTER_DRAIN) { E(acc, cur, wr, wc, fr, fq); S.done(cur); }
        if (!has_next) break;
#pragma unroll
        for (int a = 0; a < 2; ++a)
#pragma unroll
            for (int b = 0; b < 2; ++b)
#pragma unroll
                for (int m = 0; m < 4; ++m)
#pragma unroll
                    for (int n = 0; n < 2; ++n) acc[a][b][m][n] = (f32x4){0.f, 0.f, 0.f, 0.f};
        cur = nxt; cA = nA; cB = nB; ++ui;
        if constexpr (ALIGN_EPI) { if (wr == 1) PG8_BAR; }
    }
    PG8_WAIT_V(0);
    if constexpr (!ALIGN_EPI) { if (wr == 0) PG8_BAR; }
    PG8_BAR;
    if constexpr (Epi::AFTER_DRAIN) { E.fused(acc, cur, wr, wc, fr, fq, lds, wid, lane); S.done(cur); }
#undef PG8_SA
#undef PG8_SB
#undef PG8_STAGE
#undef PG8_LDA
#undef PG8_LDB
#undef PG8_MMA
#undef PG8_WAIT_V
#undef PG8_WAIT_L
#undef PG8_BAR
#undef PG8_SCHED
}
}
#define GAS __attribute__((address_space(1)))
#define LAS __attribute__((address_space(3)))
typedef unsigned short bf16;
typedef unsigned v4u __attribute__((ext_vector_type(4)));
typedef float f32x4 __attribute__((ext_vector_type(4)));
typedef short bf16x8 __attribute__((ext_vector_type(8)));
typedef GAS unsigned gu32;
typedef GAS unsigned long long gu64;
#define RLX_AGENT __ATOMIC_RELAXED, __HIP_MEMORY_SCOPE_AGENT
#define LDS_WAIT() asm volatile("s_waitcnt lgkmcnt(0)" ::: "memory")
#define VM_WAIT() asm volatile("s_waitcnt vmcnt(0)" ::: "memory")
__device__ __forceinline__ unsigned long long rt() { return __builtin_amdgcn_s_memrealtime(); }
__device__ __forceinline__ unsigned f2bf(float f) { unsigned u = __builtin_bit_cast(unsigned, f); return (u + 0x7fffu + ((u >> 16) & 1u)) >> 16; }
__device__ __forceinline__ unsigned pk2(float lo, float hi) { return f2bf(lo) | (f2bf(hi) << 16); }

#define XB_TMO      128
#define XB_XCNT(j)  (256  + 64 * (j))
#define XB_XSUB(j)  (1280 + 64 * (j))
#define XB_XGEN(j)  (2304 + 64 * (j))
#define XB_TOP      3328
#define XB_TOPGEN   3392
#define XCD_BAR_WORDS 3456
#define XB_SPIN_CAP (1u << 18)

__device__ __forceinline__ unsigned xb_ld(unsigned* p)              { return __hip_atomic_load(p, __ATOMIC_RELAXED, __HIP_MEMORY_SCOPE_AGENT); }
__device__ __forceinline__ unsigned xb_add(unsigned* p, unsigned v) { return __hip_atomic_fetch_add(p, v, __ATOMIC_RELAXED, __HIP_MEMORY_SCOPE_AGENT); }
__device__ __forceinline__ unsigned xb_xcc_id() { return (unsigned)__builtin_amdgcn_s_getreg((3 << 11) | 20) & 0xFu; }
#define XB_SPIN(cond, bar) do { unsigned _sp = 0; while (cond) { __builtin_amdgcn_s_sleep(1); \
    if ((++_sp & 255u) == 0u) { if (xb_ld(&(bar)[XB_TMO])) break; if (_sp > XB_SPIN_CAP) { atomicAdd(&(bar)[XB_TMO], 1u); break; } } } } while (0)

struct XcdBarrier {
    unsigned* bar; unsigned x;
    volatile LAS unsigned* st;
};

__device__ __forceinline__ XcdBarrier xcd_barrier_post(unsigned* bar, volatile LAS unsigned* st) {
    XcdBarrier b; b.bar = bar; b.x = xb_xcc_id(); b.st = st;
    if (threadIdx.x == 0) (void)xb_add(&bar[XB_XCNT(b.x)], 1u);
    return b;
}
__device__ __forceinline__ void xcd_barrier_complete(unsigned* bar, unsigned x, unsigned& nloc, unsigned& nx) {
    const unsigned G = gridDim.x * gridDim.y * gridDim.z;
    unsigned sum, cnt, mine, sp = 0u;
    for (;;) {
        sum = 0u; cnt = 0u; mine = 0u;
#pragma unroll
        for (unsigned j = 0; j < 16; ++j) { const unsigned c = xb_ld(&bar[XB_XCNT(j)]); sum += c; cnt += (c > 0u) ? 1u : 0u; mine = (j == x) ? c : mine; }
        if (sum == G) break;
        __builtin_amdgcn_s_sleep(1);
        if ((++sp & 255u) == 0u) { if (xb_ld(&bar[XB_TMO])) break; if (sp > XB_SPIN_CAP) { atomicAdd(&bar[XB_TMO], 1u); break; } }
    }
    nloc = mine > 0u ? mine : 1u; nx = cnt > 0u ? cnt : 1u;
}

__device__ __forceinline__ void xcd_barrier(const XcdBarrier& b) {
    asm volatile("s_waitcnt vmcnt(0)" ::: "memory");
    __syncthreads();
    if (threadIdx.x == 0) {
        unsigned* bar = b.bar;
        __builtin_amdgcn_s_waitcnt(0);
        unsigned nloc = b.st[0], nx = b.st[1];
        if (nloc == 0u) { xcd_barrier_complete(bar, b.x, nloc, nx); b.st[0] = nloc; b.st[1] = nx; }
        const unsigned old = xb_add(&bar[XB_XSUB(b.x)], 1u);
        const unsigned gen = old / nloc;
        if (old + 1u == (gen + 1u) * nloc) {
            __builtin_amdgcn_fence(__ATOMIC_RELEASE, "agent");
            asm volatile("s_waitcnt vmcnt(0)" ::: "memory");
            const unsigned og = xb_add(&bar[XB_TOP], 1u);
            const unsigned tg = og / nx;
            if (og + 1u == (tg + 1u) * nx) xb_add(&bar[XB_TOPGEN], 1u);
            else XB_SPIN(xb_ld(&bar[XB_TOPGEN]) == tg, bar);
            __builtin_amdgcn_fence(__ATOMIC_ACQUIRE, "agent");
            xb_add(&bar[XB_XGEN(b.x)], 1u);
            asm volatile("s_waitcnt vmcnt(0)" ::: "memory");
        } else {
            XB_SPIN(xb_ld(&bar[XB_XGEN(b.x)]) == gen, bar);
            __builtin_amdgcn_fence(__ATOMIC_ACQUIRE, "agent");
            asm volatile("s_waitcnt vmcnt(0)" ::: "memory");
        }
    }
    __syncthreads();
}

constexpr int NWAVES = 8;
#ifndef MK_SPLIT
#define MK_SPLIT 0
#endif
constexpr int DM = 4096, TP = 8192, TS = 2048, NSB = 8, NTOK = TP + NSB * TS, NMETA = 16, MPAD = NTOK + 256, INW = 9216, FF = 16384;
constexpr int META_ROW0 = NTOK;
constexpr int C_QNA = 0, C_KNA = 2048, C_VNA = 4096, C_QSW = 6144, C_KSW = 8192, C_VSW = 8704;
constexpr int MHALF = NTOK / 2;
constexpr float NORM_EPS = 1e-6f;
constexpr size_t MiB = 1u << 20;
constexpr size_t WS_CTL = 0, CTL_ZERO_BYTES = 1 * MiB;
constexpr size_t WS_WUP = 1 * MiB;
constexpr size_t WS_WDN = WS_WUP + (size_t)FF * DM * 2;
constexpr size_t WS_WOUT = WS_WDN + (size_t)FF * DM * 2;
constexpr size_t WS_WIN = WS_WOUT + (size_t)DM * DM * 2;
constexpr size_t WS_XN = WS_WIN + (size_t)INW * DM * 2;
constexpr size_t WS_PROJ = WS_XN + (size_t)MPAD * DM * 2;
constexpr size_t WS_END = WS_PROJ + (size_t)MPAD * INW * 2;
constexpr size_t WS_ATT = WS_XN;
constexpr size_t WS_H2 = WS_WOUT;
constexpr size_t WS_U = WS_PROJ;
static_assert(WS_H2 + (size_t)NTOK * DM * 2 <= WS_PROJ, "H2 overlay");
static_assert(WS_U + (size_t)MHALF * FF * 2 <= WS_END, "U overlay");
constexpr int CW_BAR = 4096;
constexpr int RING_OFF = 0, RING_BYTES = 131072;
constexpr int LDSCTL_OFF = RING_BYTES, MISC_OFF = LDSCTL_OFF + 320;
constexpr int LDS_BYTES = 147456;

struct Args { const float* in[16]; float* out; unsigned char* ws; int ph_lo, ph_hi, li, pad; };
struct Frame {
    LAS unsigned char* lds;
    volatile LAS unsigned* MISC;
    gu32* ctl;
    int tid, lane, wave;
    int vcu, G;
};

__device__ __forceinline__ float wave_sum(float v) {
#pragma unroll
    for (int o = 1; o < 64; o <<= 1) v += __shfl_xor(v, o);
    return v;
}
__device__ __forceinline__ float wave_max(float v) {
#pragma unroll
    for (int o = 1; o < 64; o <<= 1) v = fmaxf(v, __shfl_xor(v, o));
    return v;
}
__device__ __forceinline__ float bf_lo(unsigned w) { return __uint_as_float(w << 16); }
__device__ __forceinline__ float bf_hi(unsigned w) { return __uint_as_float(w & 0xffff0000u); }

__device__ __forceinline__ void p0_transpose_item(const float* W, int K, int N, bf16* WT, LAS float* scr, int item, int lane) {
    const int nblk = N / 32, kb = item / nblk, nb = item % nblk, k0 = 64 * kb, n0 = 32 * nb;
#pragma unroll 8
    for (int i = 0; i < 32; ++i) { const int kk = 2 * i + (lane >> 5); scr[kk * 33 + (lane & 31)] = W[(size_t)(k0 + kk) * N + n0 + (lane & 31)]; }
    LDS_WAIT(); asm volatile("" ::: "memory");
    const int c = lane & 7;
#pragma unroll
    for (int j = 0; j < 4; ++j) { const int n = (lane >> 3) + 8 * j; const LAS float* s = scr + (8 * c) * 33 + n;
        v4u o; o.x = pk2(s[0 * 33], s[1 * 33]); o.y = pk2(s[2 * 33], s[3 * 33]); o.z = pk2(s[4 * 33], s[5 * 33]); o.w = pk2(s[6 * 33], s[7 * 33]);
        *(GAS v4u*)(WT + (size_t)(n0 + n) * K + k0 + 8 * c) = o; }
    LDS_WAIT(); asm volatile("" ::: "memory");
}
__device__ __forceinline__ void rms_row_to_bf16(const float* xrow, const float* gain, bf16* orow, int lane) {
    const GAS f32x4* xr = (const GAS f32x4*)xrow + lane;
    f32x4 v[16]; float s = 0.f;
#pragma unroll
    for (int j = 0; j < 16; ++j) { v[j] = xr[64 * j]; s += (v[j].x * v[j].x + v[j].y * v[j].y) + (v[j].z * v[j].z + v[j].w * v[j].w); }
    const float rstd = 1.f / sqrtf(wave_sum(s) * (1.f / DM) + NORM_EPS);
    const GAS f32x4* gr = (const GAS f32x4*)gain + lane;
    GAS unsigned long long* o8 = (GAS unsigned long long*)orow + lane;
#pragma unroll
    for (int j = 0; j < 16; ++j) { const f32x4 g = gr[64 * j];
        o8[64 * j] = (unsigned long long)pk2(v[j].x * rstd * g.x, v[j].y * rstd * g.y) | ((unsigned long long)pk2(v[j].z * rstd * g.z, v[j].w * rstd * g.w) << 32); }
}
__device__ __forceinline__ void p0_prologue(Frame& F, const Args& args) {
    LAS float* scr = (LAS float*)(F.lds + RING_OFF + F.wave * 16384);
    const int gw = F.vcu * NWAVES + F.wave, NGW = F.G * NWAVES;
    constexpr int I_IN = (DM / 64) * (INW / 32), I_OUT = (DM / 64) * (DM / 32), I_UP = (DM / 64) * (FF / 32), I_DN = (FF / 64) * (DM / 32);
    constexpr int NITEMS = I_IN + I_OUT + I_UP + I_DN;
    for (int m = gw; m < MPAD; m += NGW) {
        bf16* orow = ((bf16*)(args.ws + WS_XN)) + (size_t)m * DM;
        if (m < TP) rms_row_to_bf16((args.in[0]) + (size_t)m * DM, (args.in[4]), orow, F.lane);
        else if (m < NTOK) rms_row_to_bf16((args.in[1]) + (size_t)(m - TP) * DM, (args.in[4]), orow, F.lane);
        else if (m < NTOK + NMETA) rms_row_to_bf16((args.in[2]) + (size_t)(m - NTOK) * DM, (args.in[4]), orow, F.lane);
        else { GAS v4u* o = (GAS v4u*)orow + F.lane;
#pragma unroll
            for (int j = 0; j < 8; ++j) o[64 * j] = (v4u){0u, 0u, 0u, 0u}; }
    }
    for (int it = gw; it < NITEMS; it += NGW) {
        int r = it;
        if (r < I_IN) { p0_transpose_item((args.in[5]), DM, INW, ((bf16*)(args.ws + WS_WIN)), scr, r, F.lane); continue; } r -= I_IN;
        if (r < I_OUT) { p0_transpose_item((args.in[12]), DM, DM, ((bf16*)(args.ws + WS_WOUT)), scr, r, F.lane); continue; } r -= I_OUT;
        if (r < I_UP) { p0_transpose_item((args.in[14]), DM, FF, ((bf16*)(args.ws + WS_WUP)), scr, r, F.lane); continue; } r -= I_UP;
        p0_transpose_item((args.in[15]), FF, DM, ((bf16*)(args.ws + WS_WDN)), scr, r, F.lane);
    }
}
__device__ __forceinline__ void p1b_qknorm(Frame& F, const Args& args) {
    const int gw = F.vcu * NWAVES + F.wave, NGW = F.G * NWAVES;
    const int sub = F.lane >> 4, l16 = F.lane & 15;
    for (int m = gw; m < NTOK + NMETA; m += NGW) {
        bf16* prow = ((bf16*)(args.ws + WS_PROJ)) + (size_t)m * INW;
#pragma unroll 1
        for (int step = 0; step < 13; ++step) {
            const int hd = step * 4 + sub;
            int col; const float* g;
            if (hd < 16) { col = C_QNA + hd * 128; g = (args.in[6]); } else if (hd < 32) { col = C_KNA + (hd - 16) * 128; g = (args.in[7]); }
            else if (hd < 48) { col = C_QSW + (hd - 32) * 128; g = (args.in[9]); } else { col = C_KSW + (hd - 48) * 128; g = (args.in[10]); }
            GAS v4u* p = (GAS v4u*)(prow + col + l16 * 8);
            const v4u w = *p;
            float x[8] = {bf_lo(w.x), bf_hi(w.x), bf_lo(w.y), bf_hi(w.y), bf_lo(w.z), bf_hi(w.z), bf_lo(w.w), bf_hi(w.w)};
            float s = 0.f;
#pragma unroll
            for (int j = 0; j < 8; ++j) s += x[j] * x[j];
            s += __shfl_xor(s, 1); s += __shfl_xor(s, 2); s += __shfl_xor(s, 4); s += __shfl_xor(s, 8);
            const float rstd = 1.f / sqrtf(s * (1.f / 128.f) + NORM_EPS);
            const f32x4 g0 = *(const GAS f32x4*)(g + l16 * 8), g1 = *(const GAS f32x4*)(g + l16 * 8 + 4);
            v4u o; o.x = pk2(x[0] * rstd * g0.x, x[1] * rstd * g0.y); o.y = pk2(x[2] * rstd * g0.z, x[3] * rstd * g0.w);
            o.z = pk2(x[4] * rstd * g1.x, x[5] * rstd * g1.y); o.w = pk2(x[6] * rstd * g1.z, x[7] * rstd * g1.w);
            *p = o;
        }
    }
}
__device__ __forceinline__ void p4_mlpnorm(Frame& F, const Args& args) {
    const int gw = F.vcu * NWAVES + F.wave, NGW = F.G * NWAVES;
    for (int m = gw; m < NTOK; m += NGW) rms_row_to_bf16((args.out) + (size_t)m * DM, (args.in[13]), ((bf16*)(args.ws + WS_H2)) + (size_t)m * DM, F.lane);
}
__device__ __forceinline__ int t5_tbl(int n) {
    return n < 8 ? n : (n < 12 ? 8 : (n < 16 ? 9 : (n < 23 ? 10 : (n < 32 ? 11 : (n < 46 ? 12 : (n < 64 ? 13 : (n < 91 ? 14 : 15)))))));
}
__device__ __forceinline__ void p2_attn_naive(Frame& F, const Args& args) {
    LAS float* qs = (LAS float*)(F.lds + RING_OFF + F.wave * 4096);
    LAS float* ps = qs + 128;
    LAS int* krs = (LAS int*)(ps + 320);
    const int gw = F.vcu * NWAVES + F.wave, NGW = F.G * NWAVES, lane = F.lane;
    const float scale = 0.08838834764831845f;
    for (int item = gw; item < NTOK * 32; item += NGW) {
        const int row = item >> 5, h = item & 31;
        int s0, T; if (row < TP) { s0 = 0; T = TP; } else { s0 = TP + (((row - TP) >> 11) << 11); T = TS; }
        const int t = row - s0;
        const bool na = h < 16; const int hq = h - 16;
        const int qcol = na ? C_QNA + h * 128 : C_QSW + hq * 128;
        const int kcol = na ? C_KNA + h * 128 : C_KSW + (hq >> 2) * 128;
        const int vcol = na ? C_VNA + h * 128 : C_VSW + (hq >> 2) * 128;
        { const unsigned w = *(const GAS unsigned*)(((bf16*)(args.ws + WS_PROJ)) + (size_t)row * INW + qcol + 2 * lane); qs[2 * lane] = bf_lo(w); qs[2 * lane + 1] = bf_hi(w); }
        const int nk = na ? 144 : 273;
        const int r = t >> 6, c = t & 63, rows = T >> 6;
        const int rs = min(max(r - 4, 0), rows - 8), cs = min(max(c - 8, 0), 48);
        const float sinkv = na ? -3.0e38f : (args.in[11])[na ? 0 : hq];
        float sc[5]; float mx = sinkv;
#pragma unroll
        for (int i = 0; i < 5; ++i) {
            const int j = lane + 64 * i; float s = -3.0e38f;
            if (j < nk) {
                int krow; float bias = 0.f; bool valid = true;
                if (j < 16) { krow = META_ROW0 + j; if (!na) bias = (args.in[3])[t5_tbl(16 + t - j) * 16 + hq]; }
                else if (na) { const int jj = j - 16, i8 = jj >> 4, cc = jj & 15, kr = rs + i8, kc = cs + cc; krow = s0 + kr * 64 + kc; bias = (args.in[8])[(h * 15 + (kr - r) + 7) * 31 + (kc - c) + 15]; }
                else { const int w = j - 16, tk = t - 128 + w, rel = w - 128; valid = (tk >= 0) && (tk < T); krow = s0 + (valid ? tk : t);
                       const int n = rel < 0 ? -rel : rel; bias = (args.in[3])[((rel > 0 ? 16 : 0) + t5_tbl(n)) * 16 + hq]; }
                krs[j] = krow;
                if (valid) {
                    const bf16* kp = ((bf16*)(args.ws + WS_PROJ)) + (size_t)krow * INW + kcol; float dot = 0.f;
#pragma unroll 4
                    for (int c8 = 0; c8 < 16; ++c8) { const v4u kv = *(const GAS v4u*)(kp + 8 * c8); const LAS f32x4* qq = (const LAS f32x4*)(qs + 8 * c8); const f32x4 q0 = qq[0], q1 = qq[1];
                        dot += q0.x * bf_lo(kv.x) + q0.y * bf_hi(kv.x) + q0.z * bf_lo(kv.y) + q0.w * bf_hi(kv.y) + q1.x * bf_lo(kv.z) + q1.y * bf_hi(kv.z) + q1.z * bf_lo(kv.w) + q1.w * bf_hi(kv.w); }
                    s = dot * scale + bias;
                }
            }
            sc[i] = s; mx = fmaxf(mx, s);
        }
        mx = wave_max(mx);
        float sum = 0.f;
#pragma unroll
        for (int i = 0; i < 5; ++i) { const int j = lane + 64 * i; const float p = (sc[i] > -1.0e38f) ? __expf(sc[i] - mx) : 0.f; sum += p; if (j < nk) ps[j] = p; }
        sum = wave_sum(sum); if (!na) sum += __expf(sinkv - mx);
        float a0 = 0.f, a1 = 0.f;
        const bf16* vp = ((bf16*)(args.ws + WS_PROJ)) + vcol + 2 * lane;
        for (int j = 0; j < nk; ++j) { const float p = ps[j]; const int kr = krs[j]; const unsigned w = *(const GAS unsigned*)(vp + (size_t)kr * INW); a0 += p * bf_lo(w); a1 += p * bf_hi(w); }
        const float inv = 1.f / sum;
        *(GAS unsigned*)(((bf16*)(args.ws + WS_ATT)) + (size_t)row * DM + h * 128 + 2 * lane) = pk2(a0 * inv, a1 * inv);
    }
}

constexpr int N_PHASES = 10;

__global__ void __launch_bounds__(NWAVES * 64, 2) fwd_kernel(Args args) {
    extern __shared__ __attribute__((aligned(16))) unsigned char lds[];
    Frame F;
    F.lds = (LAS unsigned char*)lds;
    F.MISC = (volatile LAS unsigned*)(F.lds + MISC_OFF);
    F.tid = threadIdx.x; F.lane = F.tid & 63; F.wave = __builtin_amdgcn_readfirstlane(F.tid >> 6);
    F.G = gridDim.x; { const int bx = blockIdx.x; F.vcu = (F.G % 8 == 0) ? (bx % 8) * (F.G / 8) + bx / 8 : bx; }
    F.ctl = (gu32*)(args.ws + WS_CTL);
    for (int u = F.tid; u < (LDS_BYTES - LDSCTL_OFF) / 4; u += NWAVES * 64) ((LAS unsigned*)(F.lds + LDSCTL_OFF))[u] = 0u;
    __syncthreads();
    XcdBarrier bar; bar.bar = (unsigned*)(F.ctl + CW_BAR); bar.x = 0; bar.st = nullptr;
    if (!MK_SPLIT) bar = xcd_barrier_post((unsigned*)(F.ctl + CW_BAR), F.MISC + 8);
    const int lo = args.ph_lo, hi = args.ph_hi;
#define IN(k) (lo <= (k) && (k) < hi)
#define SEAM(k) do { if (IN(k) && IN((k) + 1)) xcd_barrier(bar); } while (0)

    if (IN(0)) { p0_prologue(F, args); } SEAM(0);
    if (IN(1)) {
        pg8::Gemm g{((bf16*)(args.ws + WS_XN)), ((bf16*)(args.ws + WS_WIN)), MPAD, INW, DM}; pg8::StaticOrder S; S.init(MPAD, INW, F.G, (int)blockIdx.x);
        pg8::EpiBf16<0> E{((bf16*)(args.ws + WS_PROJ)), INW, 0};
        pg8::gemm_phase<pg8::EpiBf16<0>, pg8::StaticOrder, true, true>(F.lds + RING_OFF, g, S, E);
    } SEAM(1);
    if (IN(2)) { p1b_qknorm(F, args); } SEAM(2);
    if (IN(3)) { p2_attn_naive(F, args); } SEAM(3);
    if (IN(4)) {
        pg8::Gemm g{((bf16*)(args.ws + WS_ATT)), ((bf16*)(args.ws + WS_WOUT)), NTOK, DM, DM}; pg8::StaticOrder S; S.init(NTOK, DM, F.G, (int)blockIdx.x);
        pg8::EpiResF32 E{(args.in[0]), (args.in[1]), TP / 256, (args.out), DM};
        pg8::gemm_phase<pg8::EpiResF32, pg8::StaticOrder, true, true>(F.lds + RING_OFF, g, S, E);
    } SEAM(4);
    if (IN(5)) { p4_mlpnorm(F, args); } SEAM(5);
#pragma unroll
    for (int half = 0; half < 2; ++half) {
        if (IN(6 + 2 * half)) {
            pg8::Gemm g{((bf16*)(args.ws + WS_H2)) + (size_t)half * MHALF * DM, ((bf16*)(args.ws + WS_WUP)), MHALF, FF, DM}; pg8::StaticOrder S; S.init(MHALF, FF, F.G, (int)blockIdx.x);
            pg8::EpiBf16<1> E{((bf16*)(args.ws + WS_U)), FF, 0};
            pg8::gemm_phase<pg8::EpiBf16<1>, pg8::StaticOrder, true, true>(F.lds + RING_OFF, g, S, E);
        } SEAM(6 + 2 * half);
        if (IN(7 + 2 * half)) {
            float* o = (args.out) + (size_t)half * MHALF * DM;
            pg8::Gemm g{((bf16*)(args.ws + WS_U)), ((bf16*)(args.ws + WS_WDN)), MHALF, DM, FF}; pg8::StaticOrder S; S.init(MHALF, DM, F.G, (int)blockIdx.x);
            pg8::EpiResF32 E{o, o, 1 << 30, o, DM};
            pg8::gemm_phase<pg8::EpiResF32, pg8::StaticOrder, true, true>(F.lds + RING_OFF, g, S, E);
        }
        if (half == 0) SEAM(7);
    }
#undef IN
#undef SEAM
}

extern "C" void kernel_launch(void* const* d_in, const int* in_sizes, int n_in, void* d_out, int out_size, void* d_ws, size_t ws_size, hipStream_t stream) {
    static int grid = 0;
    if (grid == 0) {
        if (n_in != 16 || in_sizes[0] != TP * DM || in_sizes[1] != NSB * TS * DM || out_size != NTOK * DM || ws_size < WS_END) {
            fprintf(stderr, "kernel_launch: shape mismatch n_in %d in0 %d in1 %d out %d ws %zu (need %zu)\n", n_in, n_in > 0 ? in_sizes[0] : -1, n_in > 1 ? in_sizes[1] : -1, out_size, ws_size, (size_t)WS_END); grid = -1; return; }
        int dev = 0, cus = 0, per_cu = 0;
        if (hipGetDevice(&dev) != hipSuccess || hipDeviceGetAttribute(&cus, hipDeviceAttributeMultiprocessorCount, dev) != hipSuccess) { grid = -1; return; }
        if (hipFuncSetAttribute((const void*)fwd_kernel, hipFuncAttributeMaxDynamicSharedMemorySize, LDS_BYTES) != hipSuccess) { fprintf(stderr, "kernel_launch: hipFuncSetAttribute failed\n"); grid = -1; return; }
        if (hipOccupancyMaxActiveBlocksPerMultiprocessor(&per_cu, (const void*)fwd_kernel, NWAVES * 64, LDS_BYTES) != hipSuccess || per_cu < 1)
            fprintf(stderr, "kernel_launch: occupancy query reports %d\n", per_cu);
        (void)hipGetLastError();
        grid = cus;
    }
    if (grid < 0) return;
    if (hipMemsetAsync((char*)d_ws + WS_CTL, 0, CTL_ZERO_BYTES, stream) != hipSuccess) return;
    Args a{};
    for (int i = 0; i < 16; ++i) a.in[i] = (const float*)d_in[i];
    a.out = (float*)d_out; a.ws = (unsigned char*)d_ws; a.pad = 0;
#if MK_SPLIT
    for (int p = 0; p < N_PHASES; ++p) { a.ph_lo = p; a.ph_hi = p + 1; a.li = p; hipLaunchKernelGGL(fwd_kernel, dim3(grid), dim3(NWAVES * 64), LDS_BYTES, stream, a); }
#else
    a.ph_lo = 0; a.ph_hi = N_PHASES; a.li = 0;
    hipLaunchKernelGGL(fwd_kernel, dim3(grid), dim3(NWAVES * 64), LDS_BYTES, stream, a);
#endif
    const hipError_t le = hipPeekAtLastError();
    if (le != hipSuccess) fprintf(stderr, "kernel_launch: launch failed: %s\n", hipGetErrorName(le));
}
```

```cpp
#include <hip/hip_runtime.h>
#include <cstdio>
#include <cstdint>
namespace pg8 {
__device__ __forceinline__ void glds16(const void* sbase  , unsigned voff  , unsigned lds_dst  ) {
    asm volatile("s_mov_b32 m0, %2\n\ts_nop 0\n\tglobal_load_lds_dwordx4 %0, %1" :: "v"(voff), "s"(sbase), "s"(lds_dst) : "memory", "m0"); }
__device__ __forceinline__ int lane_id() { unsigned z = 0u; asm volatile("" : "+v"(z)); return (int)__builtin_amdgcn_mbcnt_hi(~0u, __builtin_amdgcn_mbcnt_lo(~0u, z)); }
#define I8_SA 30.0f
#define I8_SB 1920.0f
#define I8_DESCALE (1.0f / (I8_SA * I8_SB))
#define F8_SH_A 5
#define F8_SH_B 11
#define F8_DESCALE (1.0f / (float)(1 << (F8_SH_A + F8_SH_B)))
#define PG8_LAS __attribute__((address_space(3)))
typedef unsigned short bf16_t;
typedef short bf16x8 __attribute__((ext_vector_type(8)));
typedef float f32x4 __attribute__((ext_vector_type(4)));
typedef unsigned u32x4 __attribute__((ext_vector_type(4)));
constexpr int BM = 256, BK = 64, HALF = 128, HTB = HALF * BK * 2  , STAGE_BYTES = 8 * HTB, NXCD = 8, WGM = 8;

__host__ __device__ __forceinline__ int lds_byte(int r, int c) { const int st = (r >> 4) * 2 + (c >> 5), rr = r & 15, cc = c & 31, ob = rr * 64 + cc * 2; return st * 1024 + (ob ^ (((ob >> 9) & 1) << 5)); }
__host__ __device__ __forceinline__ void stage_rc(int b, int& R, int& C) { const int st = b / 1024, sb = b % 1024, swz = sb ^ (((sb >> 9) & 1) << 5); R = (st >> 1) * 16 + swz / 64; C = (st & 1) * 32 + (swz % 64) / 2; }
__host__ __device__ __forceinline__ int perm32(int rho) { const int n = rho >> 4, i = rho & 15; return 8 * (i >> 2) + 4 * n + (i & 3); }

struct Unit { int pm, pn; };
struct Gemm { const bf16_t* A; const bf16_t* Bt; int M, N, K, lda, ldb; unsigned ksa, ksb; size_t tsa, tsb; };
__host__ __device__ __forceinline__ Gemm gemm_rm(const bf16_t* A, int lda, const bf16_t* Bt, int ldb, int M, int N, int K) { return Gemm{A, Bt, M, N, K, lda, ldb, 128u, 128u, (size_t)512 * lda, (size_t)512 * ldb}; }
__host__ __device__ __forceinline__ Gemm gemm_tiled(const bf16_t* A, const bf16_t* Bt, int M, int N, int K) { return Gemm{A, Bt, M, N, K, 64, 64, 32768u, 32768u, (size_t)(K / 64) * 32768, (size_t)(K / 64) * 32768}; }

struct StaticOrder {
    int nM, nN, nwg, G, c, wgm;
    __host__ __device__ void init(int M, int N, int G_, int c_, int wgm_ = WGM) { nM = M / BM; nN = N / BM; nwg = nM * nN; G = G_; c = c_; wgm = wgm_; }
    __host__ __device__ bool next(int i, Unit& u) const {
        const long L = (long)i * G + c; if (L >= nwg) return false;
        if (wgm == 0) {
            const int x = c & 7, j = c >> 3; u.pm = i * 16 + 8 * (x >> 2) + (j & 7); u.pn = 4 * (x & 3) + (j >> 3); return true; }
        int wgid = (int)L; { const int q = nwg / NXCD, r = nwg % NXCD, xcd = wgid % NXCD, off = wgid / NXCD; wgid = (xcd < r ? xcd * (q + 1) : r * (q + 1) + (xcd - r) * q) + off; }
        const int nig = wgm * nN, gid = wgid / nig, fm = gid * wgm, gsz = (nM - fm) < wgm ? (nM - fm) : wgm;
        u.pm = fm + ((wgid % nig) % gsz); u.pn = (wgid % nig) / gsz; return true;
    }
    __device__ __forceinline__ void a_ready(const Unit&) const {}
    __device__ __forceinline__ void done(const Unit&) const {}
};


__device__ __forceinline__ unsigned cvt_pk_bf16(float lo, float hi) { unsigned r; asm volatile("v_cvt_pk_bf16_f32 %0, %1, %2" : "=v"(r) : "v"(lo), "v"(hi)); return r; }

template <int ACT, bool TILED = false> struct EpiBf16 {
    static constexpr bool PERM = true, AFTER_DRAIN = false, HAS_INIT = false, FUSED_NEXT = false;
    bf16_t* O; int ldc; int row_off;
    __device__ __forceinline__ void operator()(const f32x4 (&acc)[2][2][4][2], const Unit& u, int wr, int wc, int fr, int fq) const {
        const int row0 = row_off + u.pm * BM + wr * 64 + fr; const int col0 = u.pn * BM + wc * 32 + 8 * fq;
        bf16_t* tb = O + ((size_t)(u.pm * (ldc >> 6) + u.pn * 4 + (wc >> 1)) * 256 + wr * 64 + fr) * 64 + (wc & 1) * 32 + 8 * fq;
#pragma unroll
        for (int ai = 0; ai < 2; ++ai)
#pragma unroll
            for (int m = 0; m < 4; ++m) { bf16_t* rowp = TILED ? tb + (size_t)(ai * HALF + m * 16) * 64 : O + (size_t)(row0 + ai * HALF + m * 16) * ldc + col0;
#pragma unroll
                for (int bj = 0; bj < 2; ++bj) { f32x4 v0 = acc[ai][bj][m][0], v1 = acc[ai][bj][m][1];
                    if (ACT == 1) {
#pragma unroll
                        for (int j = 0; j < 4; ++j) { const float a = fmaxf(v0[j], 0.f), b = fmaxf(v1[j], 0.f); v0[j] = a * a; v1[j] = b * b; } }
                    u32x4 w; w.x = cvt_pk_bf16(v0[0], v0[1]); w.y = cvt_pk_bf16(v0[2], v0[3]); w.z = cvt_pk_bf16(v1[0], v1[1]); w.w = cvt_pk_bf16(v1[2], v1[3]);
                    *(u32x4*)(rowp + (TILED ? bj * 2 * 256 * 64 : bj * HALF)) = w; } }
    }
};
struct EpiResF32 {
    static constexpr bool PERM = false, AFTER_DRAIN = false, HAS_INIT = true, FUSED_NEXT = false;
    float* out; int ldc; const float* ssq; int live; const bf16_t* xb;
    __device__ __forceinline__ void init(f32x4 (&acc)[2][2][4][2], const Unit& u, int wr, int wc, int fr, int fq) const {
        typedef unsigned u32x2v __attribute__((ext_vector_type(2)));
        const int r0 = wr * 64 + fr; const float* sp = ssq + u.pm * BM;
        const bf16_t* xt = xb + ((size_t)(u.pm * (ldc >> 6) + u.pn * 4 + (wc >> 1)) * 256 + r0) * 64 + (wc & 1) * 32 + 4 * fq;
#pragma unroll
        for (int ai = 0; ai < 2; ++ai)
#pragma unroll
            for (int m = 0; m < 4; ++m) { const int r = r0 + ai * HALF + m * 16; const float iv = sp[r] * (1.f / 4096.f) + 1e-6f;
#pragma unroll
                for (int bj = 0; bj < 2; ++bj)
#pragma unroll
                    for (int n = 0; n < 2; ++n) { const u32x2v w = *(const u32x2v*)(xt + (size_t)(ai * HALF + m * 16) * 64 + (size_t)bj * 2 * 256 * 64 + n * 16);
                        acc[ai][bj][m][n] = (f32x4){__uint_as_float(w.x << 16), __uint_as_float(w.x & 0xffff0000u), __uint_as_float(w.y << 16), __uint_as_float(w.y & 0xffff0000u)} * iv; } }
    }
    __device__ __forceinline__ void operator()(const f32x4 (&acc)[2][2][4][2], const Unit& u, int wr, int wc, int fr, int fq) const {
        const int r0 = wr * 64 + fr, col0 = u.pn * BM + wc * 32 + 4 * fq;
        float* op = out + (size_t)u.pm * BM * ldc; const float* sp = ssq + u.pm * BM;
        float rs[8];
#pragma unroll
        for (int gi = 0; gi < 8; ++gi) rs[gi] = sp[r0 + (gi >> 2) * HALF + (gi & 3) * 16];
#pragma unroll
        for (int gi = 0; gi < 8; ++gi) rs[gi] = __builtin_amdgcn_rcpf(rs[gi] * (1.f / 4096.f) + 1e-6f);
        if (live)
#pragma unroll
        for (int gi = 0; gi < 8; ++gi) { const int ai = gi >> 2, m = gi & 3; float* q = op + (size_t)(r0 + ai * HALF + m * 16) * ldc + col0;
#pragma unroll
            for (int bj = 0; bj < 2; ++bj)
#pragma unroll
                for (int n = 0; n < 2; ++n) *(f32x4*)(q + bj * HALF + n * 16) = acc[ai][bj][m][n] * rs[gi]; }
    }
};
typedef int v4i_acc __attribute__((ext_vector_type(4)));
__device__ __forceinline__ f32x4 cvf(f32x4 a) { return __builtin_convertvector(__builtin_bit_cast(v4i_acc, a), f32x4); }
struct EpiProjNorm {
    static constexpr bool PERM = true, AFTER_DRAIN = false, HAS_INIT = false, FUSED_NEXT = false;
    bf16_t* O; int ldc; PG8_LAS float* xl; const PG8_LAS float* gl;
    __device__ __forceinline__ void operator()(f32x4 (&acc)[2][2][4][2], const Unit& u, int wr, int wc, int fr_, int fq_) const {
#pragma unroll
        for (int ai = 0; ai < 2; ++ai)
#pragma unroll
            for (int bj = 0; bj < 2; ++bj)
#pragma unroll
                for (int m = 0; m < 4; ++m)
#pragma unroll
                    for (int n = 0; n < 2; ++n) acc[ai][bj][m][n] = cvf(acc[ai][bj][m][n]);
        const int ln = lane_id(), fr = ln & 15, fq = ln >> 4; (void)fr_; (void)fq_;
        const int row0 = u.pm * BM + wr * 64 + fr; const int col0 = u.pn * BM + wc * 32 + 8 * fq;
        const int pn = u.pn;
        const int gsel = pn < 8 ? 0 : (pn < 16 ? 1 : ((pn >= 24 && pn < 32) ? 2 : ((pn >= 32 && pn < 34) ? 3 : -1)));
        if (gsel < 0) {
#pragma unroll
            for (int ai = 0; ai < 2; ++ai)
#pragma unroll
                for (int m = 0; m < 4; ++m) { bf16_t* rowp = O + (size_t)(row0 + ai * HALF + m * 16) * ldc + col0;
#pragma unroll
                    for (int bj = 0; bj < 2; ++bj) { const f32x4 v0 = acc[ai][bj][m][0] * I8_DESCALE, v1 = acc[ai][bj][m][1] * I8_DESCALE;
                        u32x4 w; w.x = cvt_pk_bf16(v0[0], v0[1]); w.y = cvt_pk_bf16(v0[2], v0[3]); w.z = cvt_pk_bf16(v1[0], v1[1]); w.w = cvt_pk_bf16(v1[2], v1[3]);
                        *(u32x4*)(rowp + bj * HALF) = w; } }
        } else {
#pragma unroll
            for (int ai = 0; ai < 2; ++ai)
#pragma unroll
                for (int m = 0; m < 4; ++m)
#pragma unroll
                    for (int bj = 0; bj < 2; ++bj) { const f32x4 a = acc[ai][bj][m][0], b = acc[ai][bj][m][1];
                        float s = (a[0] * a[0] + a[1] * a[1]) + (a[2] * a[2] + a[3] * a[3]) + (b[0] * b[0] + b[1] * b[1]) + (b[2] * b[2] + b[3] * b[3]);
                        { unsigned sa = __builtin_bit_cast(unsigned, s), sb = sa; asm volatile("" : "+v"(sb)); auto rr = __builtin_amdgcn_permlane16_swap(sa, sb, false, false); unsigned r0 = rr[0], r1 = rr[1]; asm volatile("" : "+v"(r0), "+v"(r1)); s = __builtin_bit_cast(float, r0) + __builtin_bit_cast(float, r1); }
                        { unsigned sa = __builtin_bit_cast(unsigned, s), sb = sa; asm volatile("" : "+v"(sb)); auto rr = __builtin_amdgcn_permlane32_swap(sa, sb, false, false); unsigned r0 = rr[0], r1 = rr[1]; asm volatile("" : "+v"(r0), "+v"(r1)); s = __builtin_bit_cast(float, r0) + __builtin_bit_cast(float, r1); }
                        if (fq == 0) xl[((ai * HALF + wr * 64 + m * 16 + fr) * 2 + bj) * 4 + wc] = s; }
            asm volatile("s_waitcnt lgkmcnt(0)" ::: "memory"); __builtin_amdgcn_s_barrier(); asm volatile("" ::: "memory");
            const PG8_LAS float* gp = gl + gsel * 128 + wc * 32 + 8 * fq;
            const f32x4 g0 = *(const PG8_LAS f32x4*)gp, g1 = *(const PG8_LAS f32x4*)(gp + 4);
#pragma unroll
            for (int ai = 0; ai < 2; ++ai)
#pragma unroll
                for (int m = 0; m < 4; ++m) { bf16_t* rowp = O + (size_t)(row0 + ai * HALF + m * 16) * ldc + col0;
#pragma unroll
                    for (int bj = 0; bj < 2; ++bj) { const f32x4 p = *(const PG8_LAS f32x4*)(xl + ((ai * HALF + wr * 64 + m * 16 + fr) * 2 + bj) * 4);
                        const float rstd = __builtin_amdgcn_rsqf(((p[0] + p[1]) + (p[2] + p[3])) * (I8_DESCALE * I8_DESCALE / 128.f) + 1e-6f) * I8_DESCALE;
                        const f32x4 v0 = acc[ai][bj][m][0] * rstd * g0, v1 = acc[ai][bj][m][1] * rstd * g1;
                        u32x4 w; w.x = cvt_pk_bf16(v0[0], v0[1]); w.y = cvt_pk_bf16(v0[2], v0[3]); w.z = cvt_pk_bf16(v1[0], v1[1]); w.w = cvt_pk_bf16(v1[2], v1[3]);
                        *(u32x4*)(rowp + bj * HALF) = w; } }
            asm volatile("s_waitcnt lgkmcnt(0)" ::: "memory"); __builtin_amdgcn_s_barrier(); asm volatile("" ::: "memory");
        }
    }
};
struct EpiResStats {
    static constexpr bool PERM = false, AFTER_DRAIN = false, HAS_INIT = true, FUSED_NEXT = true;
    const float* base0; const float* base1; int split; float* out; bf16_t* xb; float* ssq; int ldc; int live;
    __device__ __forceinline__ void init(f32x4 (&acc)[2][2][4][2], const Unit& u, int wr, int wc, int fr_, int fq_) const {
        const int ln = lane_id(), fr = ln & 15, fq = ln >> 4; (void)fr_; (void)fq_;
        const int r0 = wr * 64 + fr, col0 = u.pn * BM + wc * 32 + 4 * fq;
        const float* bp = (u.pm < split) ? base0 + (size_t)u.pm * BM * ldc : base1 + (size_t)(u.pm - split) * BM * ldc;
#pragma unroll
        for (int ai = 0; ai < 2; ++ai)
#pragma unroll
            for (int m = 0; m < 4; ++m) { const float* p = bp + (size_t)(r0 + ai * HALF + m * 16) * ldc + col0;
#pragma unroll
                for (int bj = 0; bj < 2; ++bj)
#pragma unroll
                    for (int n = 0; n < 2; ++n) acc[ai][bj][m][n] = *(const f32x4*)(p + bj * HALF + n * 16) * (1.0f / F8_DESCALE); }
    }
    __device__ __forceinline__ void scale(f32x4 (&acc)[2][2][4][2]) const {
#pragma unroll
        for (int ai = 0; ai < 2; ++ai)
#pragma unroll
            for (int bj = 0; bj < 2; ++bj)
#pragma unroll
                for (int m = 0; m < 4; ++m)
#pragma unroll
                    for (int n = 0; n < 2; ++n) acc[ai][bj][m][n] *= (1.0f / F8_DESCALE);
    }
    __device__ __forceinline__ void fused(f32x4 (&acc)[2][2][4][2], const Unit& u, const Unit& nx, const bool has_next, int wr, int wc) const {
        typedef unsigned u32x2v __attribute__((ext_vector_type(2)));
        const int ln = lane_id(), fr = ln & 15, fq = ln >> 4;
        const int r0 = wr * 64 + fr, col0 = u.pn * BM + wc * 32 + 4 * fq;
        const float* bpn = (nx.pm < split) ? base0 + (size_t)nx.pm * BM * ldc : base1 + (size_t)(nx.pm - split) * BM * ldc;
        const int col0n = nx.pn * BM + wc * 32 + 4 * fq;
        float* sp = ssq + u.pm * BM;
        bf16_t* xt = xb + ((size_t)(u.pm * (ldc >> 6) + u.pn * 4 + (wc >> 1)) * 256 + r0) * 64 + (wc & 1) * 32 + 4 * fq;
        if (live)
#pragma unroll
        for (int ai = 0; ai < 2; ++ai)
#pragma unroll
            for (int m = 0; m < 4; ++m) { const int r = r0 + ai * HALF + m * 16;
                float s = 0.f;
#pragma unroll
                for (int bj = 0; bj < 2; ++bj)
#pragma unroll
                    for (int n = 0; n < 2; ++n) { const f32x4 v = acc[ai][bj][m][n] * F8_DESCALE;
                        u32x2v w; w.x = cvt_pk_bf16(v[0], v[1]); w.y = cvt_pk_bf16(v[2], v[3]); *(u32x2v*)(xt + (size_t)(ai * HALF + m * 16) * 64 + (size_t)bj * 2 * 256 * 64 + n * 16) = w;
                        s += (v[0] * v[0] + v[1] * v[1]) + (v[2] * v[2] + v[3] * v[3]); }
                { unsigned sa = __builtin_bit_cast(unsigned, s), sb = sa; asm volatile("" : "+v"(sb)); auto rr = __builtin_amdgcn_permlane16_swap(sa, sb, false, false); unsigned r0 = rr[0], r1 = rr[1]; asm volatile("" : "+v"(r0), "+v"(r1)); s = __builtin_bit_cast(float, r0) + __builtin_bit_cast(float, r1); }
                { unsigned sa = __builtin_bit_cast(unsigned, s), sb = sa; asm volatile("" : "+v"(sb)); auto rr = __builtin_amdgcn_permlane32_swap(sa, sb, false, false); unsigned r0 = rr[0], r1 = rr[1]; asm volatile("" : "+v"(r0), "+v"(r1)); s = __builtin_bit_cast(float, r0) + __builtin_bit_cast(float, r1); }
                if (fq == 0) __hip_atomic_fetch_add(sp + r, s, __ATOMIC_RELAXED, __HIP_MEMORY_SCOPE_AGENT);
                if (has_next) { const float* p = bpn + (size_t)(r0 + ai * HALF + m * 16) * ldc + col0n;
#pragma unroll
                    for (int bj = 0; bj < 2; ++bj)
#pragma unroll
                        for (int n = 0; n < 2; ++n) acc[ai][bj][m][n] = *(const f32x4*)(p + bj * HALF + n * 16); } }
    }
};

typedef int v8i_t __attribute__((ext_vector_type(8)));
typedef int v4i_t __attribute__((ext_vector_type(4)));
template <bool F8> struct Frag;
template <> struct Frag<false> { v4i_t v[2]; };
template <> struct Frag<true> { v8i_t v; };
template <bool F8> __device__ __forceinline__ void fset(Frag<F8>& f, int k, v4i_t x) { if constexpr (F8) { if (k == 0) f.v.lo = x; else f.v.hi = x; } else f.v[k] = x; }
template <int MODE> __device__ __forceinline__ f32x4 fmma(const Frag<MODE == 1>& b, const Frag<MODE == 1>& a, f32x4 c) {
    if constexpr (MODE == 1) return __builtin_amdgcn_mfma_scale_f32_16x16x128_f8f6f4(b.v, a.v, c, 0, 0, 0, 0, 0, 0);
    else if constexpr (MODE == 2) { v4i_t ci = __builtin_bit_cast(v4i_t, c); ci = __builtin_amdgcn_mfma_i32_16x16x64_i8(b.v[0], a.v[0], ci, 0, 0, 0); ci = __builtin_amdgcn_mfma_i32_16x16x64_i8(b.v[1], a.v[1], ci, 0, 0, 0); return __builtin_bit_cast(f32x4, ci); }
    else { c = __builtin_amdgcn_mfma_f32_16x16x32_bf16(__builtin_bit_cast(bf16x8, b.v[0]), __builtin_bit_cast(bf16x8, a.v[0]), c, 0, 0, 0); return __builtin_amdgcn_mfma_f32_16x16x32_bf16(__builtin_bit_cast(bf16x8, b.v[1]), __builtin_bit_cast(bf16x8, a.v[1]), c, 0, 0, 0); }
}
template <class Epi, class Sched, bool ALIGN_EPI = false, bool SP2 = false, int MODE = 0>
__device__ __forceinline__ void gemm_phase(PG8_LAS unsigned char* lds, const Gemm g, const Sched& S, const Epi& E, const int wave  ) {
    const int lane = lane_id(), wid = wave, tid = wave * 64 + lane, wr = wid >> 2, wc = wid & 3, fr = lane & 15, fq = lane >> 4;
    const int K = g.K, nt = K / BK;
    unsigned voffA[2], voffB[2];
#pragma unroll
    for (int i = 0; i < 2; ++i) { int R, C; stage_rc(tid * 16 + i * 8192, R, C); const int Rb = Epi::PERM ? ((R & ~31) + perm32(R & 31)) : R;
        voffA[i] = (unsigned)(R * g.lda + C) * 2u; voffB[i] = (unsigned)(Rb * g.ldb + C) * 2u; }
    const size_t kstepA = g.ksa, kstepB = g.ksb;
    const size_t hstepA = (size_t)HALF * g.lda * 2, hstepB = (size_t)HALF * g.ldb * 2;
    const size_t tstepA = g.tsa, tstepB = g.tsb;
    const unsigned ldsa = (unsigned)__builtin_amdgcn_readfirstlane((int)((unsigned)(size_t)lds + (unsigned)wid * 1024u));
    const int aoff = lds_byte(wr * 64 + fr, fq * 8), boff = lds_byte(wc * 32 + fr, fq * 8);
#define PG8_SA(b, h) (((b) * 2 + (h)) * HTB)
#define PG8_SB(b, h) ((4 + (b) * 2 + (h)) * HTB)
#define PG8_STAGE(bufoff, gbase, voff) do { _Pragma("unroll") for (int _i = 0; _i < 2; ++_i) pg8::glds16((const char*)(gbase), (voff)[_i], ldsa + (unsigned)((bufoff) + _i * 8192)); } while (0)
#define PG8_LDA(dst, b, h) do { _Pragma("unroll") for (int m = 0; m < 4; ++m) _Pragma("unroll") for (int k = 0; k < 2; ++k) pg8::fset<(MODE == 1)>(dst[m], k, *(const PG8_LAS v4i_t*)(lds + PG8_SA(b, h) + aoff + m * 2048 + k * 1024)); } while (0)
#define PG8_LDB(dst, b, h) do { _Pragma("unroll") for (int n = 0; n < 2; ++n) _Pragma("unroll") for (int k = 0; k < 2; ++k) pg8::fset<(MODE == 1)>(dst[n], k, *(const PG8_LAS v4i_t*)(lds + PG8_SB(b, h) + boff + n * 2048 + k * 1024)); } while (0)
#define PG8_MMA(ai, bj, At, Bt) do { __builtin_amdgcn_s_setprio(1); _Pragma("unroll") for (int m = 0; m < 4; ++m) _Pragma("unroll") for (int n = 0; n < 2; ++n) acc[ai][bj][m][n] = pg8::fmma<MODE>(Bt[n], At[m], acc[ai][bj][m][n]); __builtin_amdgcn_s_setprio(0); } while (0)
#define PG8_WAIT_V(n) asm volatile("s_waitcnt vmcnt(" #n ")" ::: "memory")
#define PG8_WAIT_L(n) asm volatile("s_waitcnt lgkmcnt(" #n ")" ::: "memory")
#define PG8_BAR __builtin_amdgcn_s_barrier()
#define PG8_SCHED __builtin_amdgcn_sched_barrier(0)
    Unit cur, nxt; int ui = 0;
    if (!S.next(0, cur)) return;
    f32x4 acc[2][2][4][2];
    if constexpr (Epi::HAS_INIT) E.init(acc, cur, wr, wc, fr, fq);
    else {
#pragma unroll
    for (int a = 0; a < 2; ++a)
#pragma unroll
        for (int b = 0; b < 2; ++b)
#pragma unroll
            for (int m = 0; m < 4; ++m)
#pragma unroll
                for (int n = 0; n < 2; ++n) acc[a][b][m][n] = (f32x4){0.f, 0.f, 0.f, 0.f};
    }
    Frag<(MODE == 1)> At[4], B0[2], B1[2];
    const char* cA = (const char*)g.A + (size_t)cur.pm * tstepA; const char* cB = (const char*)g.Bt + (size_t)cur.pn * tstepB;
    S.a_ready(cur);
    if constexpr (SP2) {
        PG8_STAGE(PG8_SB(0, 0), cB, voffB); PG8_STAGE(PG8_SB(0, 1), cB + hstepB, voffB); PG8_STAGE(PG8_SA(0, 0), cA, voffA); PG8_STAGE(PG8_SA(0, 1), cA + hstepA, voffA);
        if (wr == 1) PG8_BAR;
        PG8_WAIT_V(2); PG8_BAR;
        PG8_STAGE(PG8_SB(1, 0), cB + kstepB, voffB); PG8_STAGE(PG8_SA(1, 0), cA + kstepA, voffA); PG8_STAGE(PG8_SB(1, 1), cB + hstepB + kstepB, voffB);
        PG8_WAIT_V(6); PG8_BAR;
    } else {
        PG8_STAGE(PG8_SB(0, 0), cB, voffB); PG8_STAGE(PG8_SA(0, 0), cA, voffA); PG8_STAGE(PG8_SB(0, 1), cB + hstepB, voffB); PG8_STAGE(PG8_SA(0, 1), cA + hstepA, voffA);
        if (wr == 1) PG8_BAR;
        PG8_WAIT_V(4); PG8_BAR;
        PG8_STAGE(PG8_SB(1, 0), cB + kstepB, voffB); PG8_STAGE(PG8_SA(1, 0), cA + kstepA, voffA); PG8_STAGE(PG8_SB(1, 1), cB + hstepB + kstepB, voffB);
        PG8_WAIT_V(6); PG8_BAR;
    }
    for (;;) {
        const bool has_next = S.next(ui + 1, nxt);
        const char* nA = has_next ? (const char*)g.A + (size_t)nxt.pm * tstepA : cA; const char* nB = has_next ? (const char*)g.Bt + (size_t)nxt.pn * tstepB : cB;
        for (int t = 0; t < nt; t += 2) {
            const bool last = (t == nt - 2);
            const char* a1 = cA + (size_t)(t + 1) * kstepA;
            const char* a2 = last ? nA : cA + (size_t)(t + 2) * kstepA; const char* b2 = last ? nB : cB + (size_t)(t + 2) * kstepB;
            const char* a3 = a2 + kstepA; const char* b3 = b2 + kstepB;
            if (last && has_next) S.a_ready(nxt);
            if constexpr (SP2) {
            PG8_LDB(B0, 0, 0); PG8_LDB(B1, 0, 1); PG8_SCHED; PG8_LDA(At, 0, 0); PG8_STAGE(PG8_SA(1, 1), a1 + hstepA, voffA);
            PG8_WAIT_V(8); PG8_WAIT_L(0); PG8_BAR; PG8_MMA(0, 0, At, B0); PG8_MMA(0, 1, At, B1); PG8_BAR; PG8_SCHED;
            PG8_LDA(At, 0, 1); PG8_STAGE(PG8_SB(0, 0), b2, voffB); PG8_STAGE(PG8_SB(0, 1), b2 + hstepB, voffB); PG8_STAGE(PG8_SA(0, 0), a2, voffA);
            PG8_WAIT_V(8); PG8_WAIT_L(0); PG8_BAR; PG8_MMA(1, 0, At, B0); PG8_MMA(1, 1, At, B1); PG8_BAR; PG8_SCHED;
            PG8_LDB(B0, 1, 0); PG8_LDB(B1, 1, 1); PG8_SCHED; PG8_LDA(At, 1, 0); PG8_STAGE(PG8_SA(0, 1), a2 + hstepA, voffA);
            PG8_WAIT_V(8); PG8_WAIT_L(0); PG8_BAR; PG8_MMA(0, 0, At, B0); PG8_MMA(0, 1, At, B1); PG8_BAR; PG8_SCHED;
            PG8_LDA(At, 1, 1); PG8_STAGE(PG8_SB(1, 0), b3, voffB); PG8_STAGE(PG8_SB(1, 1), b3 + hstepB, voffB); PG8_STAGE(PG8_SA(1, 0), a3, voffA);
            PG8_WAIT_V(8); PG8_WAIT_L(0); PG8_BAR; PG8_MMA(1, 0, At, B0); PG8_MMA(1, 1, At, B1); PG8_BAR; PG8_SCHED;
            } else {
            PG8_LDB(B0, 0, 0); PG8_SCHED; PG8_LDA(At, 0, 0); PG8_STAGE(PG8_SA(1, 1), a1 + hstepA, voffA);
            PG8_WAIT_L(8); PG8_BAR; PG8_WAIT_L(0); PG8_MMA(0, 0, At, B0); PG8_BAR; PG8_SCHED;
            PG8_LDB(B1, 0, 1); PG8_STAGE(PG8_SB(0, 0), b2, voffB);
            PG8_BAR; PG8_WAIT_L(0); PG8_MMA(0, 1, At, B1); PG8_BAR;
            PG8_LDA(At, 0, 1); PG8_STAGE(PG8_SA(0, 0), a2, voffA);
            PG8_BAR; PG8_WAIT_L(0); PG8_MMA(1, 0, At, B0); PG8_BAR; PG8_SCHED;
            PG8_STAGE(PG8_SB(0, 1), b2 + hstepB, voffB);
            PG8_WAIT_V(6); PG8_BAR; PG8_MMA(1, 1, At, B1); PG8_BAR;
            PG8_LDB(B0, 1, 0); PG8_SCHED; PG8_LDA(At, 1, 0); PG8_STAGE(PG8_SA(0, 1), a2 + hstepA, voffA);
            PG8_WAIT_L(8); PG8_BAR; PG8_WAIT_L(0); PG8_MMA(0, 0, At, B0); PG8_BAR; PG8_SCHED;
            PG8_LDB(B1, 1, 1); PG8_STAGE(PG8_SB(1, 0), b3, voffB);
            PG8_BAR; PG8_WAIT_L(0); PG8_MMA(0, 1, At, B1); PG8_BAR;
            PG8_LDA(At, 1, 1); PG8_STAGE(PG8_SA(1, 0), a3, voffA);
            PG8_BAR; PG8_WAIT_L(0); PG8_MMA(1, 0, At, B0); PG8_BAR; PG8_SCHED;
            PG8_STAGE(PG8_SB(1, 1), b3 + hstepB, voffB);
            PG8_WAIT_V(6); PG8_BAR; PG8_MMA(1, 1, At, B1); PG8_BAR;
            }
        }
        if constexpr (ALIGN_EPI) { if (wr == 0) PG8_BAR; }
        if constexpr (Epi::FUSED_NEXT) { E.fused(acc, cur, nxt, has_next, wr, wc); S.done(cur); }
        else if constexpr (!Epi::AFTER_DRAIN) { E(acc, cur, wr, wc, fr, fq); S.done(cur); }
        if (!has_next) break;
        if constexpr (Epi::FUSED_NEXT) E.scale(acc);
        else if constexpr (Epi::HAS_INIT) E.init(acc, nxt, wr, wc, fr, fq);
        else {
#pragma unroll
        for (int a = 0; a < 2; ++a)
#pragma unroll
            for (int b = 0; b < 2; ++b)
#pragma unroll
                for (int m = 0; m < 4; ++m)
#pragma unroll
                    for (int n = 0; n < 2; ++n) acc[a][b][m][n] = (f32x4){0.f, 0.f, 0.f, 0.f};
        }
        cur = nxt; cA = nA; cB = nB; ++ui;
        if constexpr (ALIGN_EPI) { if (wr == 1) PG8_BAR; }
    }
    PG8_WAIT_V(0);
    if constexpr (!ALIGN_EPI) { if (wr == 0) PG8_BAR; }
    PG8_BAR;
    if constexpr (Epi::AFTER_DRAIN) { E.fused(acc, cur, wr, wc, fr, fq, lds, wid, lane); S.done(cur); }
#undef PG8_SA
#undef PG8_SB
#undef PG8_STAGE
#undef PG8_LDA
#undef PG8_LDB
#undef PG8_MMA
#undef PG8_WAIT_V
#undef PG8_WAIT_L
#undef PG8_BAR
#undef PG8_SCHED
}
}
#define GAS __attribute__((address_space(1)))
#define LAS __attribute__((address_space(3)))
typedef unsigned short bf16;
typedef unsigned v4u __attribute__((ext_vector_type(4)));
typedef float f32x4 __attribute__((ext_vector_type(4)));
typedef short bf16x8 __attribute__((ext_vector_type(8)));
typedef GAS unsigned gu32;
typedef GAS unsigned long long gu64;
#define RLX_AGENT __ATOMIC_RELAXED, __HIP_MEMORY_SCOPE_AGENT
#define LDS_WAIT() asm volatile("s_waitcnt lgkmcnt(0)" ::: "memory")
#define VM_WAIT() asm volatile("s_waitcnt vmcnt(0)" ::: "memory")
__device__ __forceinline__ unsigned long long rt() { return __builtin_amdgcn_s_memrealtime(); }
__device__ __forceinline__ unsigned f2bf(float f) { unsigned u = __builtin_bit_cast(unsigned, f); return (u + 0x7fffu + ((u >> 16) & 1u)) >> 16; }
__device__ __forceinline__ unsigned pk2(float lo, float hi) { return f2bf(lo) | (f2bf(hi) << 16); }
#ifndef WDROP_MLP
#define WDROP_MLP 2
#endif
__device__ __forceinline__ unsigned f2bfw(float f, int drop) { const int S = 16 + drop; unsigned u = __builtin_bit_cast(unsigned, f); return ((u + ((1u << (S - 1)) - 1u) + ((u >> S) & 1u)) >> S) << drop; }
__device__ __forceinline__ unsigned pk2w(float lo, float hi, int drop) { return f2bfw(lo, drop) | (f2bfw(hi, drop) << 16); }

#define XB_TMO      128
#define XB_XCNT(j)  (256  + 64 * (j))
#define XB_XSUB(j)  (1280 + 64 * (j))
#define XB_XGEN(j)  (2304 + 64 * (j))
#define XB_TOP      3328
#define XB_TOPGEN   3392
#define XCD_BAR_WORDS 3456
#define XB_SPIN_CAP (1u << 18)

__device__ __forceinline__ unsigned xb_ld(unsigned* p)              { return __hip_atomic_load(p, __ATOMIC_RELAXED, __HIP_MEMORY_SCOPE_AGENT); }
__device__ __forceinline__ unsigned xb_add(unsigned* p, unsigned v) { return __hip_atomic_fetch_add(p, v, __ATOMIC_RELAXED, __HIP_MEMORY_SCOPE_AGENT); }
__device__ __forceinline__ unsigned xb_xcc_id() { return (unsigned)__builtin_amdgcn_s_getreg((3 << 11) | 20) & 0xFu; }
#define XB_SPIN(cond, bar) do { unsigned _sp = 0; while (cond) { __builtin_amdgcn_s_sleep(1); \
    if ((++_sp & 255u) == 0u) { if (xb_ld(&(bar)[XB_TMO])) break; if (_sp > XB_SPIN_CAP) { atomicAdd(&(bar)[XB_TMO], 1u); break; } } } } while (0)

struct XcdBarrier {
    unsigned w0;
    unsigned* bar; unsigned x;
    volatile LAS unsigned* st;
};

__device__ __forceinline__ XcdBarrier xcd_barrier_post(unsigned* bar, volatile LAS unsigned* st) {
    XcdBarrier b; b.bar = bar; b.x = xb_xcc_id(); b.st = st; b.w0 = (__builtin_amdgcn_readfirstlane(threadIdx.x >> 6) == 0) ? 1u : 0u;
    if (threadIdx.x == 0) (void)xb_add(&bar[XB_XCNT(b.x)], 1u);
    return b;
}
__device__ __forceinline__ void xcd_barrier_complete(unsigned* bar, unsigned x, unsigned& nloc, unsigned& nx) {
    const unsigned G = gridDim.x * gridDim.y * gridDim.z;
    unsigned sum, cnt, mine, sp = 0u;
    for (;;) {
        sum = 0u; cnt = 0u; mine = 0u;
#pragma unroll
        for (unsigned j = 0; j < 16; ++j) { const unsigned c = xb_ld(&bar[XB_XCNT(j)]); sum += c; cnt += (c > 0u) ? 1u : 0u; mine = (j == x) ? c : mine; }
        if (sum == G) break;
        __builtin_amdgcn_s_sleep(1);
        if ((++sp & 255u) == 0u) { if (xb_ld(&bar[XB_TMO])) break; if (sp > XB_SPIN_CAP) { atomicAdd(&bar[XB_TMO], 1u); break; } }
    }
    nloc = mine > 0u ? mine : 1u; nx = cnt > 0u ? cnt : 1u;
}

__device__ __forceinline__ void xcd_barrier(const XcdBarrier& b) {
    asm volatile("s_waitcnt vmcnt(0)" ::: "memory");
    __syncthreads();
    if (b.w0 && pg8::lane_id() == 0) {
        unsigned* bar = b.bar;
        __builtin_amdgcn_s_waitcnt(0);
        unsigned nloc = b.st[0], nx = b.st[1];
        if (nloc == 0u) { xcd_barrier_complete(bar, b.x, nloc, nx); b.st[0] = nloc; b.st[1] = nx; }
        const unsigned old = xb_add(&bar[XB_XSUB(b.x)], 1u);
        const unsigned gen = old / nloc;
        if (old + 1u == (gen + 1u) * nloc) {
            __builtin_amdgcn_fence(__ATOMIC_RELEASE, "agent");
            asm volatile("s_waitcnt vmcnt(0)" ::: "memory");
            const unsigned og = xb_add(&bar[XB_TOP], 1u);
            const unsigned tg = og / nx;
            if (og + 1u == (tg + 1u) * nx) xb_add(&bar[XB_TOPGEN], 1u);
            else XB_SPIN(xb_ld(&bar[XB_TOPGEN]) == tg, bar);
            __builtin_amdgcn_fence(__ATOMIC_ACQUIRE, "agent");
            xb_add(&bar[XB_XGEN(b.x)], 1u);
            asm volatile("s_waitcnt vmcnt(0)" ::: "memory");
        } else {
            XB_SPIN(xb_ld(&bar[XB_XGEN(b.x)]) == gen, bar);
            __builtin_amdgcn_fence(__ATOMIC_ACQUIRE, "agent");
            asm volatile("s_waitcnt vmcnt(0)" ::: "memory");
        }
    }
    __syncthreads();
}

constexpr int NWAVES = 8;
#ifndef REP_P0
#ifndef P0X
#define P0X 7
#endif
#define REP_P0 1
#endif
#ifndef REP_INPROJ
#define REP_INPROJ 1
#endif
#ifndef REP_DOWN
#define REP_DOWN 1
#endif
#ifndef REP_OUT
#define REP_OUT 1
#endif
#ifndef REP_UP
#define REP_UP 1
#endif
#ifndef DOWN_WGM
#define DOWN_WGM 0
#endif
#ifndef ATT_REPS
#define ATT_REPS 1
#endif
#ifndef MK_SPLIT
#define MK_SPLIT 0
#endif
constexpr int DM = 4096, TP = 8192, TS = 2048, NSB = 8, NTOK = TP + NSB * TS, NMETA = 16, MPAD = NTOK + 256, INW = 9216, FF = 16384;
constexpr int META_ROW0 = NTOK;
constexpr int C_QNA = 0, C_KNA = 2048, C_VNA = 4096, C_QSW = 6144, C_KSW = 8192, C_VSW = 8704;
#ifndef MLP_NCH
#define MLP_NCH 3
#endif
constexpr int NCH = MLP_NCH, MHALF = NTOK / NCH;
static_assert(NTOK % (NCH * 256) == 0, "MLP chunking");
constexpr int FFP = FF;
constexpr float NORM_EPS = 1e-6f;
constexpr size_t MiB = 1u << 20;
constexpr size_t WS_CTL = 0, CTL_ZERO_BYTES = 1 * MiB;
constexpr size_t WS_WUP = 1 * MiB;
constexpr size_t WS_WDN = WS_WUP + (size_t)FF * DM * 2;
constexpr size_t WS_WOUT = WS_WDN + (size_t)FFP * DM * 2;
constexpr size_t WS_WIN = WS_WOUT + (size_t)DM * DM * 2;
constexpr size_t WS_XN = WS_WIN + (size_t)INW * DM * 2;
constexpr size_t WS_PROJ = WS_XN + (size_t)MPAD * DM * 2;
constexpr size_t WS_END = WS_PROJ + (size_t)MPAD * INW * 2;
constexpr size_t WS_ATT = WS_XN;
constexpr size_t WS_U = WS_WOUT;
constexpr size_t WS_H2 = (WS_U + (size_t)MHALF * FFP * 2 > WS_PROJ) ? WS_U + (size_t)MHALF * FFP * 2 : WS_PROJ;
static_assert(WS_H2 >= WS_PROJ && WS_H2 + (size_t)NTOK * DM * 2 <= WS_END, "H2 placement");
constexpr int CW_BAR = 4096;
constexpr int CW_SSQ = 65536;
static_assert((CW_SSQ + NTOK) * 4 <= (int)CTL_ZERO_BYTES, "ssq inside the memset region");
constexpr int RING_OFF = 0, RING_BYTES = 131072;
constexpr int LDSCTL_OFF = RING_BYTES, MISC_OFF = LDSCTL_OFF + 320;
constexpr int XL_OFF = MISC_OFF + 128, GL_OFF = XL_OFF + 8192;
constexpr int LDS_BYTES = 147456;
static_assert(GL_OFF + 2048 <= LDS_BYTES && (XL_OFF % 16) == 0, "LDS map");

struct Args { const float* in[16]; float* out; unsigned char* ws; int ph_lo, ph_hi, rep_p0, rep_inproj, li, rep_up, rep_out, pad; };
struct Frame {
    LAS unsigned char* lds;
    volatile LAS unsigned* MISC;
    gu32* ctl;
    int wave;
    int vcu, G;
};

__device__ __forceinline__ float wave_sum(float v) {
#pragma unroll
    for (int o = 1; o < 64; o <<= 1) v += __shfl_xor(v, o);
    return v;
}
__device__ __forceinline__ float wave_max(float v) {
#pragma unroll
    for (int o = 1; o < 64; o <<= 1) v = fmaxf(v, __shfl_xor(v, o));
    return v;
}
__device__ __forceinline__ float bf_lo(unsigned w) { return __uint_as_float(w << 16); }
__device__ __forceinline__ float bf_hi(unsigned w) { return __uint_as_float(w & 0xffff0000u); }

__device__ __forceinline__ void p0_transpose_item(const float* W, int K, int N, bf16* WT, LAS float* scr, int item, int lane, int drop, const float* gk = nullptr, int ldt = 0) {
    if (ldt == 0) ldt = K;
    const int nblk = N / 32, kb = item / nblk, nb = item % nblk, k0 = 64 * kb, n0 = 32 * nb;
    const int c = lane & 7;
    f32x4 g0 = {1.f, 1.f, 1.f, 1.f}, g1 = g0;
    if (gk) { g0 = *(const GAS f32x4*)(gk + k0 + 8 * c); g1 = *(const GAS f32x4*)(gk + k0 + 8 * c + 4); }
#pragma unroll
    for (int i = 0; i < 32; ++i) { const int kk = 2 * i + (lane >> 5); scr[kk * 33 + (lane & 31)] = W[(size_t)(k0 + kk) * N + n0 + (lane & 31)]; }
    LDS_WAIT(); asm volatile("" ::: "memory");
#pragma unroll
    for (int j = 0; j < 4; ++j) { const int n = (lane >> 3) + 8 * j; const LAS float* s = scr + (8 * c) * 33 + n;
        v4u o; o.x = pk2w(s[0 * 33] * g0[0], s[1 * 33] * g0[1], drop); o.y = pk2w(s[2 * 33] * g0[2], s[3 * 33] * g0[3], drop); o.z = pk2w(s[4 * 33] * g1[0], s[5 * 33] * g1[1], drop); o.w = pk2w(s[6 * 33] * g1[2], s[7 * 33] * g1[3], drop);
        *(GAS v4u*)(WT + (ldt < 0 ? ((size_t)(((n0 + n) >> 8) * (K >> 6) + kb) * 256 + ((n0 + n) & 255)) * 64 + 8 * c : (size_t)(n0 + n) * ldt + k0 + 8 * c)) = o; }
    LDS_WAIT(); asm volatile("" ::: "memory");
}
__host__ __device__ __forceinline__ size_t tiled_off(int row, int col) { return ((size_t)((row >> 8) * (DM / 64) + (col >> 6)) * 256 + (row & 255)) * 64 + (col & 63); }
__device__ __forceinline__ unsigned pk4_i8(float a, float b, float c, float d) {
    const float M = 12582912.f;
    const unsigned t0 = __builtin_bit_cast(unsigned, __builtin_amdgcn_fmed3f(a, -127.f, 127.f) + M), t1 = __builtin_bit_cast(unsigned, __builtin_amdgcn_fmed3f(b, -127.f, 127.f) + M);
    const unsigned t2 = __builtin_bit_cast(unsigned, __builtin_amdgcn_fmed3f(c, -127.f, 127.f) + M), t3 = __builtin_bit_cast(unsigned, __builtin_amdgcn_fmed3f(d, -127.f, 127.f) + M);
    return __builtin_amdgcn_perm(t1, t0, 0x0c0c0400u) | (__builtin_amdgcn_perm(t3, t2, 0x0c0c0400u) << 16);
}
__device__ __forceinline__ void rms_row_to_f8(const float* xrow, const float* gain, unsigned char* obase, int orow, int lane) {
    const GAS f32x4* xr = (const GAS f32x4*)xrow + lane;
    f32x4 v[16]; float s = 0.f;
#pragma unroll
    for (int j = 0; j < 16; ++j) { v[j] = xr[64 * j]; s += (v[j].x * v[j].x + v[j].y * v[j].y) + (v[j].z * v[j].z + v[j].w * v[j].w); }
    const float rstd = I8_SA / sqrtf(wave_sum(s) * (1.f / DM) + NORM_EPS);
    const GAS f32x4* gr = (const GAS f32x4*)gain + lane;
    unsigned char* ob = obase + ((size_t)((orow >> 8) * (DM / 128) + (lane >> 5)) * 256 + (orow & 255)) * 128 + 4 * (lane & 31);
#pragma unroll
    for (int j = 0; j < 16; ++j) { const f32x4 g = gr[64 * j];
        const unsigned w = pk4_i8(v[j].x * rstd * g.x, v[j].y * rstd * g.y, v[j].z * rstd * g.z, v[j].w * rstd * g.w);
        *(GAS unsigned*)(ob + (size_t)(2 * j) * 32768) = w; }
}
template <bool HEADMAP>
__device__ __forceinline__ void p0_w8_item(const float* W, int N, unsigned char* W8, LAS float* scr, int item, int lane) {
    const int nblk = N / 32, kt = item / nblk, nb = item % nblk, k0 = 128 * kt, n0 = 32 * nb;
#define W8_SWZ(kk) ((HEADMAP ? (((kk) >> 2) & 7) : (((kk) >> 4) & 7)) << 2)
#pragma unroll 16
    for (int i = 0; i < 64; ++i) { const int kk = 2 * i + (lane >> 5), n = lane & 31; scr[kk * 32 + (n ^ W8_SWZ(kk))] = W[(size_t)(k0 + kk) * N + n0 + n]; }
    LDS_WAIT(); asm volatile("" ::: "memory");
    const int c = lane & 7; const float sc = HEADMAP ? (float)(1 << F8_SH_B) : I8_SB;
#pragma unroll
    for (int j = 0; j < 4; ++j) { const int n = (lane >> 3) + 8 * j; unsigned o4[4];
#pragma unroll
        for (int w = 0; w < 4; ++w) { float f[4];
#pragma unroll
            for (int b = 0; b < 4; ++b) { const int t = 4 * w + b; const int kk = HEADMAP ? 32 * (t & 3) + 4 * c + (t >> 2) : 16 * c + t;
                f[b] = scr[kk * 32 + (n ^ W8_SWZ(kk))] * sc; }
            unsigned x = 0;
            if (HEADMAP) { x = __builtin_amdgcn_cvt_pk_fp8_f32(__builtin_amdgcn_fmed3f(f[0], -448.f, 448.f), __builtin_amdgcn_fmed3f(f[1], -448.f, 448.f), x, false); x = __builtin_amdgcn_cvt_pk_fp8_f32(__builtin_amdgcn_fmed3f(f[2], -448.f, 448.f), __builtin_amdgcn_fmed3f(f[3], -448.f, 448.f), x, true); }
            else x = pk4_i8(f[0], f[1], f[2], f[3]);
            o4[w] = x; }
        *(GAS v4u*)(W8 + ((size_t)(((n0 + n) >> 8) * 32 + kt) * 256 + ((n0 + n) & 255)) * 128 + 16 * c) = (v4u){o4[0], o4[1], o4[2], o4[3]}; }
#undef W8_SWZ
    LDS_WAIT(); asm volatile("" ::: "memory");
}
__device__ __forceinline__ void p0_prologue(Frame& F, const Args& args, const int parts = 7) {
    LAS float* scr = (LAS float*)(F.lds + RING_OFF + F.wave * 16384);
    const int gw = F.vcu * NWAVES + F.wave, NGW = F.G * NWAVES, lane0 = pg8::lane_id();
    constexpr int I_IN = (DM / 128) * (INW / 32), I_OUT = (DM / 128) * (DM / 32), I_UP = (DM / 64) * (FF / 32), I_DN = (FF / 64) * (DM / 32);
    constexpr int NITEMS = I_IN + I_OUT + I_UP + I_DN;
    if (parts & 1)
    for (int m = gw; m < MPAD; m += NGW) {
        unsigned char* xn = args.ws + WS_XN;
        if (m < TP) rms_row_to_f8((args.in[0]) + (size_t)m * DM, (args.in[4]), xn, m, lane0);
        else if (m < NTOK) rms_row_to_f8((args.in[1]) + (size_t)(m - TP) * DM, (args.in[4]), xn, m, lane0);
        else if (m < NTOK + NMETA) rms_row_to_f8((args.in[2]) + (size_t)(m - NTOK) * DM, (args.in[4]), xn, m, lane0);
        else {
#pragma unroll
            for (int j = 0; j < 16; ++j) *(GAS unsigned*)(xn + ((size_t)((m >> 8) * (DM / 128) + 2 * j + (lane0 >> 5)) * 256 + (m & 255)) * 128 + 4 * (lane0 & 31)) = 0u; }
    }
    for (int it = (parts & 2) ? gw : gw + ((I_IN + I_OUT - gw + NGW - 1) / NGW) * NGW; it < ((parts & 4) ? NITEMS : I_IN + I_OUT); it += NGW) {
        int r = it;
        if (r < I_IN) { p0_w8_item<false>((args.in[5]), INW, args.ws + WS_WIN, scr, r, lane0); continue; } r -= I_IN;
        if (r < I_OUT) { p0_w8_item<true>((args.in[12]), DM, args.ws + WS_WOUT, scr, r, lane0); continue; } r -= I_OUT;
        if (r < I_UP) { p0_transpose_item((args.in[14]), DM, FF, ((bf16*)(args.ws + WS_WUP)), scr, r, lane0, WDROP_MLP, (args.in[13]), -1); continue; } r -= I_UP;
        p0_transpose_item((args.in[15]), FF, DM, ((bf16*)(args.ws + WS_WDN)), scr, r, lane0, WDROP_MLP, nullptr, -1);
    }
}
__device__ __forceinline__ int t5_tbl(int n) {
    return n < 8 ? n : (n < 12 ? 8 : (n < 16 ? 9 : (n < 23 ? 10 : (n < 32 ? 11 : (n < 46 ? 12 : (n < 64 ? 13 : (n < 91 ? 14 : 15)))))));
}

namespace att {
using bf16x8 = __attribute__((ext_vector_type(8))) short;
using s16x4  = __attribute__((ext_vector_type(4))) short;
using f32x16 = __attribute__((ext_vector_type(16))) float;
using u32x4  = __attribute__((ext_vector_type(4))) unsigned;
constexpr float LOG2E = 1.4426950408889634f, CS = 0.08838834764831845f * LOG2E, THRL = 11.0f, NEG = -1.0e30f;
constexpr int SHM_V = 16384, SHM_K = 16384;
constexpr int L_V = 0, L_K = 2 * SHM_V, L_WS = L_K + 2 * SHM_K, L_LUT = L_WS + 8 * 256;
constexpr int L_MV = 81920, L_MK = L_MV + SHM_V;
static_assert(L_LUT + 8192 <= L_MV && L_MK + SHM_K <= 131072, "attention LDS map");
#define KSWZ(row, colB) ((row) * 256 + ((colB) ^ (((row) & 7) << 4)))
#define SBAR() __builtin_amdgcn_sched_barrier(0)
__device__ __forceinline__ int crow(int r, int hi) { return (r & 3) + 8 * (r >> 2) + 4 * hi; }
__device__ __forceinline__ unsigned cvtpk(float lo, float hi) { unsigned r; asm volatile("v_cvt_pk_bf16_f32 %0, %1, %2" : "=v"(r) : "v"(lo), "v"(hi)); return r; }
__device__ __forceinline__ int v_st(int k, int c) { const int kk = (k & ~0xC) | ((k & 4) << 1) | ((k & 8) >> 1); return ((kk >> 3) * 4 + (c >> 5)) * 512 + ((kk & 7) * 32 + (c & 31)) * 2; }
__device__ __forceinline__ int v_rd_base(int lane) { return ((lane & 3) << 3) | (((lane >> 2) & 3) << 6) | (((lane >> 4) & 1) << 5) | (((lane >> 5) & 1) << 8); }
constexpr int v_rd_off(int d0, int ks, int half) { return d0 * 512 + ks * 4096 + half * 2048; }
template <int OFF> __device__ __forceinline__ s16x4 tr_read(int vb) {
  s16x4 r; asm volatile("ds_read_b64_tr_b16 %0, %1 offset:%2" : "=&v"(r) : "v"(vb), "i"(OFF) : "memory"); return r;
}
#define PKV(L, H) (bf16x8){L[0], L[1], L[2], L[3], H[0], H[1], H[2], H[3]}
template <int D0> __device__ __forceinline__ void pv_one(f32x16& od, int vb, bf16x8 pa0, bf16x8 pa1, bf16x8 pa2, bf16x8 pa3) {
  const s16x4 l0 = tr_read<v_rd_off(D0, 0, 0)>(vb), h0 = tr_read<v_rd_off(D0, 0, 1)>(vb), l1 = tr_read<v_rd_off(D0, 1, 0)>(vb), h1 = tr_read<v_rd_off(D0, 1, 1)>(vb);
  const s16x4 l2 = tr_read<v_rd_off(D0, 2, 0)>(vb), h2 = tr_read<v_rd_off(D0, 2, 1)>(vb), l3 = tr_read<v_rd_off(D0, 3, 0)>(vb), h3 = tr_read<v_rd_off(D0, 3, 1)>(vb);
  asm volatile("s_waitcnt lgkmcnt(0)" ::: "memory"); SBAR();
  od = __builtin_amdgcn_mfma_f32_32x32x16_bf16(pa0, PKV(l0, h0), od, 0, 0, 0);
  od = __builtin_amdgcn_mfma_f32_32x32x16_bf16(pa1, PKV(l1, h1), od, 0, 0, 0);
  od = __builtin_amdgcn_mfma_f32_32x32x16_bf16(pa2, PKV(l2, h2), od, 0, 0, 0);
  od = __builtin_amdgcn_mfma_f32_32x32x16_bf16(pa3, PKV(l3, h3), od, 0, 0, 0);
}
template <int D0> __device__ __forceinline__ void pv_one16(f32x16& od, int vb, bf16x8 pa0) {
  const s16x4 l0 = tr_read<v_rd_off(D0, 0, 0)>(vb), h0 = tr_read<v_rd_off(D0, 0, 1)>(vb);
  asm volatile("s_waitcnt lgkmcnt(0)" ::: "memory"); SBAR();
  od = __builtin_amdgcn_mfma_f32_32x32x16_bf16(pa0, PKV(l0, h0), od, 0, 0, 0);
}
#define PK4(P, BASE, OUT) do { unsigned a0 = cvtpk(P[BASE + 0], P[BASE + 1]), a1 = cvtpk(P[BASE + 2], P[BASE + 3]);   \
    unsigned b0 = cvtpk(P[BASE + 4], P[BASE + 5]), b1 = cvtpk(P[BASE + 6], P[BASE + 7]);                              \
    auto r0_ = __builtin_amdgcn_permlane32_swap(a0, b0, false, false); auto r1_ = __builtin_amdgcn_permlane32_swap(a1, b1, false, false); \
    u32x4 w_ = {r0_[0], r1_[0], r0_[1], r1_[1]}; OUT = *reinterpret_cast<bf16x8*>(&w_); } while (0)

template <int MODE>
__device__ __forceinline__ void tile_step(const LAS char* Kt, const int vb, const bf16x8 (&qr)[8], f32x16 (&o)[4], float& m_reg, float& l_reg,
                                          LAS float* al_l, const int r32, const int hi, const LAS float* lutp, const int ucs) {
  f32x16 p0 = {}, p1 = {};
#pragma unroll
  for (int d0 = 0; d0 < 8; ++d0) { const int cb = (d0 * 16 + hi * 8) * 2;
    const bf16x8 b0 = *reinterpret_cast<const LAS bf16x8*>(Kt + KSWZ(r32, cb));
    p0 = __builtin_amdgcn_mfma_f32_32x32x16_bf16(b0, qr[d0], p0, 0, 0, 0);
    if (MODE >= 2) { const bf16x8 b1 = *reinterpret_cast<const LAS bf16x8*>(Kt + KSWZ(32 + r32, cb)); p1 = __builtin_amdgcn_mfma_f32_32x32x16_bf16(b1, qr[d0], p1, 0, 0, 0); }
    if ((d0 & 3) == 3) SBAR(); }
#pragma unroll
  for (int r = 0; r < 16; ++r) { const int ki = (r & 3) + 8 * (r >> 2);
    if (MODE == 0) p0[r] = (r < 8) ? p0[r] * CS : NEG;
    if (MODE == 1) p0[r] = (r < 8) ? fmaf(p0[r], CS, lutp[ki]) : NEG;
    if (MODE == 2) { p0[r] = fmaf(p0[r], CS, lutp[ki]); p1[r] = fmaf(p1[r], CS, lutp[ki + 32]); }
    if (MODE == 3) { const float a = fmaf(p0[r], CS, lutp[ki]), b = fmaf(p1[r], CS, lutp[ki + 32]);
      p0[r] = ((unsigned)(ucs + ki) < 16u) ? a : NEG; p1[r] = ((unsigned)(ucs + ki + 32) < 16u) ? b : NEG; } }
  SBAR();
  float pmax = p0[0];
#pragma unroll
  for (int r = 1; r < 16; ++r) pmax = fmaxf(pmax, p0[r]);
  if (MODE >= 2) {
#pragma unroll
    for (int r = 0; r < 16; ++r) pmax = fmaxf(pmax, p1[r]); }
  { auto rr = __builtin_amdgcn_permlane32_swap(__float_as_uint(pmax), __float_as_uint(pmax), false, false); pmax = fmaxf(__uint_as_float(rr[0]), __uint_as_float(rr[1])); }
  float mn, alpha;
  if (__all(pmax - m_reg <= THRL)) { mn = m_reg; alpha = 1.f; }
  else { mn = fmaxf(m_reg, pmax); alpha = __builtin_amdgcn_exp2f(m_reg - mn); m_reg = mn; }
  float ps = 0.f;
#pragma unroll
  for (int r = 0; r < 16; ++r) { p0[r] = __builtin_amdgcn_exp2f(p0[r] - mn); ps += p0[r]; }
  if (MODE >= 2) {
#pragma unroll
    for (int r = 0; r < 16; ++r) { p1[r] = __builtin_amdgcn_exp2f(p1[r] - mn); ps += p1[r]; } }
  { auto rr = __builtin_amdgcn_permlane32_swap(__float_as_uint(ps), __float_as_uint(ps), false, false); ps = __uint_as_float(rr[0]) + __uint_as_float(rr[1]); }
  l_reg = l_reg * alpha + ps;
  if (__any(alpha < 1.f)) { if (hi == 0) al_l[r32] = alpha; asm volatile("s_waitcnt lgkmcnt(0)" ::: "memory");
#pragma unroll
    for (int r = 0; r < 16; ++r) { const float a = al_l[crow(r, hi)];
#pragma unroll
      for (int d = 0; d < 4; ++d) o[d][r] *= a; } }
  SBAR();
  bf16x8 pa0, pa1, pa2, pa3;
  PK4(p0, 0, pa0);
  if (MODE >= 2) { PK4(p0, 8, pa1); PK4(p1, 0, pa2); PK4(p1, 8, pa3);
    pv_one<0>(o[0], vb, pa0, pa1, pa2, pa3); pv_one<1>(o[1], vb, pa0, pa1, pa2, pa3); pv_one<2>(o[2], vb, pa0, pa1, pa2, pa3); pv_one<3>(o[3], vb, pa0, pa1, pa2, pa3); }
  else { pv_one16<0>(o[0], vb, pa0); pv_one16<1>(o[1], vb, pa0); pv_one16<2>(o[2], vb, pa0); pv_one16<3>(o[3], vb, pa0); }
}
__device__ __forceinline__ void store_o(const f32x16 (&o)[4], float l_reg, LAS float* li_l, unsigned char* ATT8  , int grow0, int ktile, int r32, int hi) {
  if (hi == 0) li_l[r32] = l_reg; asm volatile("s_waitcnt lgkmcnt(0)" ::: "memory");
#pragma unroll
  for (int r = 0; r < 16; ++r) {
    const float ia = __builtin_amdgcn_rcpf(li_l[crow(r, hi)]) * (float)(1 << F8_SH_A);
    const float x0 = __builtin_amdgcn_fmed3f(o[0][r] * ia, -448.f, 448.f), x1 = __builtin_amdgcn_fmed3f(o[1][r] * ia, -448.f, 448.f);
    const float x2 = __builtin_amdgcn_fmed3f(o[2][r] * ia, -448.f, 448.f), x3 = __builtin_amdgcn_fmed3f(o[3][r] * ia, -448.f, 448.f);
    unsigned w = 0; w = __builtin_amdgcn_cvt_pk_fp8_f32(x0, x1, w, false); w = __builtin_amdgcn_cvt_pk_fp8_f32(x2, x3, w, true);
    const int row = grow0 + crow(r, hi);
    *(GAS unsigned*)(ATT8 + ((size_t)((row >> 8) * 32 + ktile) * 256 + (row & 255)) * 128 + 4 * r32) = w; }
}
__device__ __forceinline__ void seq_of_row(int row0, int& s0, int& T) { if (row0 < TP) { s0 = 0; T = TP; } else { s0 = TP + (((row0 - TP) >> 11) << 11); T = TS; } }

__device__ __forceinline__ void dma_offsets(int wid, int lane, unsigned (&koff)[2], unsigned (&voff)[2]) {
#pragma unroll
  for (int j = 0; j < 2; ++j) { const int X = (wid * 2 + j) * 1024 + lane * 16;
    { const int row = X >> 8, chp = (X >> 4) & 15, ch = chp ^ (row & 7); koff[j] = (unsigned)(row * INW + ch * 8) * 2u; }
    { const int st = X >> 9, kk = (st >> 2) * 8 + ((X & 511) >> 6), k = (kk & ~0xC) | ((kk & 4) << 1) | ((kk & 8) >> 1), c = (st & 3) * 32 + ((X & 63) >> 1); voff[j] = (unsigned)(k * INW + c) * 2u; } }
}
#define ATT_DMA_AT(krow0, KO, VO) do { const char* gb_ = (const char*)(PROJ + (size_t)(krow0) * INW); \
    _Pragma("unroll") for (int j_ = 0; j_ < 2; ++j_) __builtin_amdgcn_global_load_lds((const unsigned*)(gb_ + kcol * 2 + koff[j_]), (LAS unsigned*)(L + (KO) + (wid * 2 + j_) * 1024), 16, 0, 0); \
    _Pragma("unroll") for (int j_ = 0; j_ < 2; ++j_) __builtin_amdgcn_global_load_lds((const unsigned*)(gb_ + vcol * 2 + voff[j_]), (LAS unsigned*)(L + (VO) + (wid * 2 + j_) * 1024), 16, 0, 0); } while (0)
#define ATT_DMA(krow0, B) ATT_DMA_AT(krow0, L_K + (B) * SHM_K, L_V + (B) * SHM_V)
#define ATT_SYNC() do { asm volatile("s_waitcnt vmcnt(0)" ::: "memory"); __syncthreads(); } while (0)

__device__ __forceinline__ void swa_phase(Frame& F, const Args& args) {
  const int wid = F.wave, lane = pg8::lane_id(), tid = wid * 64 + lane, r32 = lane & 31, hi = lane >> 5;
  LAS char* L = (LAS char*)F.lds + RING_OFF;
  LAS float* wsf = (LAS float*)(L + L_WS) + wid * 64; LAS float* li_l = wsf; LAS float* al_l = wsf + 32;
  LAS float* lut = (LAS float*)(L + L_LUT);
  const bf16* PROJ = (const bf16*)(args.ws + WS_PROJ); unsigned char* ATT = args.ws + WS_ATT;
  const float* t5 = args.in[3]; const float* sink = args.in[11];
  unsigned koff[2], voff[2]; dma_offsets(wid, lane, koff, voff);
  const int vb0 = (int)(unsigned)(size_t)(L + L_V) + v_rd_base(lane);
  const int g = wid >> 1, sub = wid & 1;
  constexpr int NU = (NTOK / 64) * 4;
  const int u_lo = (int)((long)F.vcu * NU / F.G), u_hi = (int)((long)(F.vcu + 1) * NU / F.G);
  int lut_kvh = -1;
  for (int u = u_lo; u < u_hi; ++u) {
    const int kvh = u / (NTOK / 64), blk = u % (NTOK / 64), row0 = blk * 64;
    int s0, T; seq_of_row(row0, s0, T);
    const int t0 = row0 - s0, hq = kvh * 4 + g;
    const int kcol = C_KSW + kvh * 128, vcol = C_VSW + kvh * 128;
    int tido = tid; asm volatile("" : "+v"(tido));
    const int r32o = tido & 31, hio = (tido >> 5) & 1;
    const bool newh = (kvh != lut_kvh);
    if (newh) { lut_kvh = kvh;
    for (int e = tido; e < 2048; e += 512) { const int gg = e >> 9, j = e & 511, hh = kvh * 4 + gg; float v = 0.f;
      if (j < 383) { const int rel = j - 191, n = rel < 0 ? -rel : rel; v = (n <= 128) ? t5[((rel > 0 ? 16 : 0) + t5_tbl(n)) * 16 + hh] * LOG2E : NEG; }
      else if (j >= 384 && j < 384 + 106) v = t5[t5_tbl(106 - (j - 384)) * 16 + hh] * LOG2E;
      lut[e] = v; } }
    const int tq = t0 + 32 * sub + r32o;
    bf16x8 qr[8];
    { const bf16* qp = PROJ + (size_t)(row0 + 32 * sub + r32o) * INW + C_QSW + hq * 128 + hio * 8;
#pragma unroll
      for (int d0 = 0; d0 < 8; ++d0) qr[d0] = *(const GAS bf16x8*)(qp + d0 * 16); }
    const int k_lo = t0 >= 128 ? 0 : (128 - t0) / 64, k_hi = min(4, (T + 64 - t0) / 64);
    f32x16 o[4] = {}; float m_reg = NEG, l_reg = 0.f;
    const int nw = k_hi - k_lo + 1;
    const int wrow0 = s0 + t0 - 128 + 64 * k_lo;
    const LAS float* lutw = lut + g * 512 + 64 * k_lo + 63 - 32 * sub - r32o + 4 * hio;
#define SWA_COMPUTE(j, B) tile_step<2>(L + L_K + (B) * SHM_K, vb0 + (B) * SHM_V, qr, o, m_reg, l_reg, al_l, r32, hi, lutw + 64 * (j), 0)
    if (newh) ATT_DMA_AT(META_ROW0, L_MK, L_MV);
    ATT_DMA(wrow0, 1); ATT_SYNC();
    if (nw > 1) ATT_DMA(wrow0 + 64, 0);
    tile_step<1>(L + L_MK, vb0 + L_MV, qr, o, m_reg, l_reg, al_l, r32, hi, lut + g * 512 + 384 + (90 - min(tq, 90)) + 4 * hio, 0);
    SWA_COMPUTE(0, 1); ATT_SYNC();
    for (int j = 1; j < nw; j += 2) {
      if (j + 1 < nw) ATT_DMA(wrow0 + 64 * (j + 1), 1);
      SWA_COMPUTE(j, 0); ATT_SYNC();
      if (j + 1 < nw) { if (j + 2 < nw) ATT_DMA(wrow0 + 64 * (j + 2), 0);
        SWA_COMPUTE(j + 1, 1); ATT_SYNC(); }
    }
#undef SWA_COMPUTE
    l_reg += __builtin_amdgcn_exp2f(sink[hq] * LOG2E - m_reg);
    { int tidp = tid; asm volatile("" : "+v"(tidp)); store_o(o, l_reg, li_l, ATT, row0 + 32 * sub, 16 + hq, tidp & 31, (tidp >> 5) & 1); }
  }
}
__device__ __forceinline__ void na_phase(Frame& F, const Args& args) {
  const int wid = F.wave, lane = pg8::lane_id(), tid = wid * 64 + lane, r32 = lane & 31, hi = lane >> 5;
  LAS char* L = (LAS char*)F.lds + RING_OFF;
  LAS float* wsf = (LAS float*)(L + L_WS) + wid * 64; LAS float* li_l = wsf; LAS float* al_l = wsf + 32;
  LAS float* lut = (LAS float*)(L + L_LUT);
  const bf16* PROJ = (const bf16*)(args.ws + WS_PROJ); unsigned char* ATT = args.ws + WS_ATT;
  const float* rpb = args.in[8];
  unsigned koff[2], voff[2]; dma_offsets(wid, lane, koff, voff);
  const int vb0 = (int)(unsigned)(size_t)(L + L_V) + v_rd_base(lane);
  constexpr int NU = (NTOK / 256) * 16;
  const int u_lo = (int)((long)F.vcu * NU / F.G), u_hi = (int)((long)(F.vcu + 1) * NU / F.G);
  int lut_h = -1;
  for (int u = u_lo; u < u_hi; ++u) {
    const int h = u / (NTOK / 256), blk = u % (NTOK / 256), row0 = blk * 256;
    int s0, T; seq_of_row(row0, s0, T);
    const int t0 = row0 - s0, r0 = t0 >> 6, rows = T >> 6;
    const int kcol = C_KNA + h * 128, vcol = C_VNA + h * 128;
    int tido = tid; asm volatile("" : "+v"(tido));
    const int r32o = tido & 31, hio = (tido >> 5) & 1;
    const bool newh = (h != lut_h);
    if (newh) { lut_h = h;
    for (int e = tido; e < 608; e += 512) { const int j = e - 64; float v = 0.f;
      if (j >= 0 && j < 480 && (j & 31) < 31) v = rpb[(h * 15 + (j >> 5)) * 31 + (j & 31)] * LOG2E;
      lut[e] = v; } }
    const int r = r0 + (wid >> 1), c = 32 * (wid & 1) + r32o;
    const int cs = min(max(c - 8, 0), 48), rs_w = min(max(r - 4, 0), rows - 8);
    const int kr_lo = min(max(r0 - 4, 0), rows - 8), kr_hi = min(max(r0 - 1, 0), rows - 8) + 7;
    bf16x8 qr[8];
    { const bf16* qp = PROJ + (size_t)(row0 + 32 * wid + r32o) * INW + C_QNA + h * 128 + hio * 8;
#pragma unroll
      for (int d0 = 0; d0 < 8; ++d0) qr[d0] = *(const GAS bf16x8*)(qp + d0 * 16); }
    f32x16 o[4] = {}; float m_reg = NEG, l_reg = 0.f;
    const int nw = kr_hi - kr_lo + 1;
    const int wrow0 = s0 + kr_lo * 64;
    const LAS float* lutw = lut + 64 + (kr_lo - r + 7) * 32 + 15 - c + 4 * hio;
    const int ucs = 4 * hio - cs, ja = rs_w - kr_lo;
#define NA_COMPUTE(j, B) do { if ((j) >= ja && (j) <= ja + 7) tile_step<3>(L + L_K + (B) * SHM_K, vb0 + (B) * SHM_V, qr, o, m_reg, l_reg, al_l, r32, hi, lutw + 32 * (j), ucs); } while (0)
    if (newh) ATT_DMA_AT(META_ROW0, L_MK, L_MV);
    ATT_DMA(wrow0, 1); ATT_SYNC();
    if (nw > 1) ATT_DMA(wrow0 + 64, 0);
    tile_step<0>(L + L_MK, vb0 + L_MV, qr, o, m_reg, l_reg, al_l, r32, hi, lut, 0);
    NA_COMPUTE(0, 1); ATT_SYNC();
    for (int j = 1; j < nw; j += 2) {
      if (j + 1 < nw) ATT_DMA(wrow0 + 64 * (j + 1), 1);
      NA_COMPUTE(j, 0); ATT_SYNC();
      if (j + 1 < nw) { if (j + 2 < nw) ATT_DMA(wrow0 + 64 * (j + 2), 0);
        NA_COMPUTE(j + 1, 1); ATT_SYNC(); }
    }
#undef NA_COMPUTE
    { int tidp = tid; asm volatile("" : "+v"(tidp)); store_o(o, l_reg, li_l, ATT, row0 + 32 * wid, h, tidp & 31, (tidp >> 5) & 1); }
  }
}
#undef ATT_DMA
#undef ATT_DMA_AT
#undef ATT_SYNC
#undef PK4
#undef PKV
#undef KSWZ
}

constexpr int N_PHASES = 4 + 2 * NCH;

__global__ void __launch_bounds__(NWAVES * 64, 2) fwd_kernel(Args args) {
    extern __shared__ __attribute__((aligned(16))) unsigned char lds[];
    Frame F;
    F.lds = (LAS unsigned char*)lds;
    F.MISC = (volatile LAS unsigned*)(F.lds + MISC_OFF);
    const int tid0 = threadIdx.x; F.wave = __builtin_amdgcn_readfirstlane(tid0 >> 6);
    F.G = gridDim.x; { const int bx = blockIdx.x; F.vcu = (F.G % 8 == 0) ? (bx % 8) * (F.G / 8) + bx / 8 : bx; }
    F.ctl = (gu32*)(args.ws + WS_CTL);
    for (int u = tid0; u < (LDS_BYTES - LDSCTL_OFF) / 4; u += NWAVES * 64) ((LAS unsigned*)(F.lds + LDSCTL_OFF))[u] = 0u;
    __syncthreads();
    XcdBarrier bar; bar.bar = (unsigned*)(F.ctl + CW_BAR); bar.x = 0; bar.st = nullptr; bar.w0 = 0;
    if (!MK_SPLIT) bar = xcd_barrier_post((unsigned*)(F.ctl + CW_BAR), F.MISC + 8);
    const int lo = args.ph_lo, hi = args.ph_hi;
#define IN(k) (lo <= (k) && (k) < hi)
#define SEAM(k) do { if (IN(k) && IN((k) + 1)) xcd_barrier(bar); } while (0)

    if (IN(0)) {
#pragma unroll 1
        for (int rep = 0; rep < args.rep_p0; ++rep) p0_prologue(F, args, rep == 0 ? 7 : P0X);
    } SEAM(0);
    if (IN(1)) {
        { LAS float* gl = (LAS float*)(F.lds + GL_OFF); const int t = F.wave * 64 + pg8::lane_id(); const int which = t >> 7;
          const float* gsrc = which == 0 ? args.in[6] : (which == 1 ? args.in[7] : (which == 2 ? args.in[9] : args.in[10]));
          gl[t] = gsrc[t & 127]; __syncthreads(); }
        pg8::Gemm g = pg8::gemm_tiled(((bf16*)(args.ws + WS_XN)), ((bf16*)(args.ws + WS_WIN)), MPAD, INW, DM / 2); pg8::StaticOrder S; S.init(MPAD, INW, F.G, (int)blockIdx.x);
        pg8::EpiProjNorm E{((bf16*)(args.ws + WS_PROJ)), INW, (LAS float*)(F.lds + XL_OFF), (const LAS float*)(F.lds + GL_OFF)};
#pragma unroll 1
        for (int rep = 0; rep < args.rep_inproj; ++rep) pg8::gemm_phase<pg8::EpiProjNorm, pg8::StaticOrder, true, true, 2>(F.lds + RING_OFF, g, S, E, F.wave);
    } SEAM(1);
    if (IN(2)) {
#pragma unroll 1
        for (int rep = 0; rep < args.li; ++rep) { att::swa_phase(F, args); att::na_phase(F, args); __syncthreads(); }
    } SEAM(2);
    if (IN(3)) {
        pg8::Gemm g = pg8::gemm_tiled(((bf16*)(args.ws + WS_ATT)), ((bf16*)(args.ws + WS_WOUT)), NTOK, DM, DM / 2); pg8::StaticOrder S; S.init(NTOK, DM, F.G, (int)blockIdx.x);
        pg8::EpiResStats E{(args.in[0]), (args.in[1]), TP / 256, (args.out), ((bf16*)(args.ws + WS_H2)), (float*)(args.ws + WS_CTL) + CW_SSQ, DM, 1};
#pragma unroll 1
        for (int rep = args.rep_out - 1; rep >= 0; --rep) { E.live = (rep == 0); pg8::gemm_phase<pg8::EpiResStats, pg8::StaticOrder, true, true, true>(F.lds + RING_OFF, g, S, E, F.wave); }
    } SEAM(3);
#pragma unroll 1
    for (int half = 0; half < NCH; ++half) {
        if (IN(4 + 2 * half)) {
            pg8::Gemm g = pg8::gemm_tiled(((bf16*)(args.ws + WS_H2)) + (size_t)half * MHALF * DM, ((bf16*)(args.ws + WS_WUP)), MHALF, FF, DM); pg8::StaticOrder S; S.init(MHALF, FF, F.G, (int)blockIdx.x);
            pg8::EpiBf16<1, true> E{((bf16*)(args.ws + WS_U)), FF, 0};
#pragma unroll 1
            for (int rep = 0; rep < (half == 0 ? args.rep_up : 1); ++rep) pg8::gemm_phase<pg8::EpiBf16<1, true>, pg8::StaticOrder, true, true>(F.lds + RING_OFF, g, S, E, F.wave);
        } SEAM(4 + 2 * half);
        if (IN(5 + 2 * half)) {
            float* o = (args.out) + (size_t)half * MHALF * DM;
            pg8::Gemm g = pg8::gemm_tiled(((bf16*)(args.ws + WS_U)), ((bf16*)(args.ws + WS_WDN)), MHALF, DM, FF); pg8::StaticOrder S; S.init(MHALF, DM, F.G, (int)blockIdx.x, (F.G == 256) ? DOWN_WGM : 8);
            pg8::EpiResF32 E{o, DM, (const float*)(args.ws + WS_CTL) + CW_SSQ + half * MHALF, 1, ((const bf16*)(args.ws + WS_H2)) + (size_t)half * MHALF * DM};
#pragma unroll 1
            for (int rep = (half == 0 ? args.pad : 1) - 1; rep >= 0; --rep) { E.live = (rep == 0); pg8::gemm_phase<pg8::EpiResF32, pg8::StaticOrder, true, true>(F.lds + RING_OFF, g, S, E, F.wave); }
        }
        if (half + 1 < NCH) SEAM(5 + 2 * half);
    }
#undef IN
#undef SEAM
}

extern "C" void kernel_launch(void* const* d_in, const int* in_sizes, int n_in, void* d_out, int out_size, void* d_ws, size_t ws_size, hipStream_t stream) {
    static int grid = 0;
    if (grid == 0) {
        if (n_in != 16 || in_sizes[0] != TP * DM || in_sizes[1] != NSB * TS * DM || out_size != NTOK * DM || ws_size < WS_END) {
            fprintf(stderr, "kernel_launch: shape mismatch n_in %d in0 %d in1 %d out %d ws %zu (need %zu)\n", n_in, n_in > 0 ? in_sizes[0] : -1, n_in > 1 ? in_sizes[1] : -1, out_size, ws_size, (size_t)WS_END); grid = -1; return; }
        int dev = 0, cus = 0, per_cu = 0;
        if (hipGetDevice(&dev) != hipSuccess || hipDeviceGetAttribute(&cus, hipDeviceAttributeMultiprocessorCount, dev) != hipSuccess) { grid = -1; return; }
        if (hipFuncSetAttribute((const void*)fwd_kernel, hipFuncAttributeMaxDynamicSharedMemorySize, LDS_BYTES) != hipSuccess) { fprintf(stderr, "kernel_launch: hipFuncSetAttribute failed\n"); grid = -1; return; }
        if (hipOccupancyMaxActiveBlocksPerMultiprocessor(&per_cu, (const void*)fwd_kernel, NWAVES * 64, LDS_BYTES) != hipSuccess || per_cu < 1)
            fprintf(stderr, "kernel_launch: occupancy query reports %d\n", per_cu);
        (void)hipGetLastError();
        grid = cus;
    }
    if (grid < 0) return;
    if (hipMemsetAsync((char*)d_ws + WS_CTL, 0, CTL_ZERO_BYTES, stream) != hipSuccess) return;
    Args a{};
    for (int i = 0; i < 16; ++i) a.in[i] = (const float*)d_in[i];
    a.out = (float*)d_out; a.ws = (unsigned char*)d_ws; a.rep_p0 = REP_P0; a.rep_inproj = REP_INPROJ; a.rep_up = REP_UP; a.rep_out = REP_OUT; a.pad = REP_DOWN;
#if MK_SPLIT
    for (int p = 0; p < N_PHASES; ++p) { a.ph_lo = p; a.ph_hi = p + 1; a.li = p; hipLaunchKernelGGL(fwd_kernel, dim3(grid), dim3(NWAVES * 64), LDS_BYTES, stream, a); }
#else
    a.ph_lo = 0; a.ph_hi = N_PHASES; a.li = ATT_REPS;
    hipLaunchKernelGGL(fwd_kernel, dim3(grid), dim3(NWAVES * 64), LDS_BYTES, stream, a);
#endif
    const hipError_t le = hipPeekAtLastError();
    if (le != hipSuccess) fprintf(stderr, "kernel_launch: launch failed: %s\n", hipGetErrorName(le));
}
```

```cpp
#include <hip/hip_runtime.h>
#include <cstdio>
#include <cstdint>
namespace pg8 {
__device__ __forceinline__ void glds16(const void* sbase  , unsigned voff  , unsigned lds_dst  ) {
    asm volatile("s_mov_b32 m0, %2\n\ts_nop 0\n\tglobal_load_lds_dwordx4 %0, %1" :: "v"(voff), "s"(sbase), "s"(lds_dst) : "memory", "m0"); }
__device__ __forceinline__ int lane_id() { unsigned z = 0u; asm volatile("" : "+v"(z)); return (int)__builtin_amdgcn_mbcnt_hi(~0u, __builtin_amdgcn_mbcnt_lo(~0u, z)); }
#define F6_SH_A 1
#define F6_SH_B 7
#define F6_DESCALE (1.0f / (float)(1 << (F6_SH_A + F6_SH_B)))
#define F8_SH_A 5
#define F8_SH_B 11
#define F8_DESCALE (1.0f / (float)(1 << (F8_SH_A + F8_SH_B)))
#define PG8_LAS __attribute__((address_space(3)))
typedef unsigned short bf16_t;
typedef short bf16x8 __attribute__((ext_vector_type(8)));
typedef float f32x4 __attribute__((ext_vector_type(4)));
typedef unsigned u32x4 __attribute__((ext_vector_type(4)));
constexpr int BM = 256, BK = 64, HALF = 128, HTB = HALF * BK * 2  , STAGE_BYTES = 8 * HTB, NXCD = 8, WGM = 8;

__host__ __device__ __forceinline__ int lds_byte(int r, int c) { const int st = (r >> 4) * 2 + (c >> 5), rr = r & 15, cc = c & 31, ob = rr * 64 + cc * 2; return st * 1024 + (ob ^ (((ob >> 9) & 1) << 5)); }
__host__ __device__ __forceinline__ void stage_rc(int b, int& R, int& C) { const int st = b / 1024, sb = b % 1024, swz = sb ^ (((sb >> 9) & 1) << 5); R = (st >> 1) * 16 + swz / 64; C = (st & 1) * 32 + (swz % 64) / 2; }
__host__ __device__ __forceinline__ int perm32(int rho) { const int n = rho >> 4, i = rho & 15; return 8 * (i >> 2) + 4 * n + (i & 3); }

struct Unit { int pm, pn; };
struct Gemm { const bf16_t* A; const bf16_t* Bt; int M, N, K, lda, ldb; unsigned ksa, ksb; size_t tsa, tsb; };
__host__ __device__ __forceinline__ Gemm gemm_rm(const bf16_t* A, int lda, const bf16_t* Bt, int ldb, int M, int N, int K) { return Gemm{A, Bt, M, N, K, lda, ldb, 128u, 128u, (size_t)512 * lda, (size_t)512 * ldb}; }
__host__ __device__ __forceinline__ Gemm gemm_tiled(const bf16_t* A, const bf16_t* Bt, int M, int N, int K) { return Gemm{A, Bt, M, N, K, 64, 64, 32768u, 32768u, (size_t)(K / 64) * 32768, (size_t)(K / 64) * 32768}; }

struct StaticOrder {
    int nM, nN, nwg, G, c, wgm;
    __host__ __device__ void init(int M, int N, int G_, int c_, int wgm_ = WGM) { nM = M / BM; nN = N / BM; nwg = nM * nN; G = G_; c = c_; wgm = wgm_; }
    __host__ __device__ bool next(int i, Unit& u) const {
        const long L = (long)i * G + c; if (L >= nwg) return false;
        if (wgm == 0) {
            const int x = c & 7, j = c >> 3; u.pm = i * 16 + 8 * (x >> 2) + (j & 7); u.pn = 4 * (x & 3) + (j >> 3); return true; }
        int wgid = (int)L; { const int q = nwg / NXCD, r = nwg % NXCD, xcd = wgid % NXCD, off = wgid / NXCD; wgid = (xcd < r ? xcd * (q + 1) : r * (q + 1) + (xcd - r) * q) + off; }
        const int nig = wgm * nN, gid = wgid / nig, fm = gid * wgm, gsz = (nM - fm) < wgm ? (nM - fm) : wgm;
        u.pm = fm + ((wgid % nig) % gsz); u.pn = (wgid % nig) / gsz; return true;
    }
    __device__ __forceinline__ void a_ready(const Unit&) const {}
    __device__ __forceinline__ void done(const Unit&) const {}
};


__device__ __forceinline__ unsigned cvt_pk_bf16(float lo, float hi) { unsigned r; asm volatile("v_cvt_pk_bf16_f32 %0, %1, %2" : "=v"(r) : "v"(lo), "v"(hi)); return r; }

template <int ACT, bool TILED = false> struct EpiBf16 {
    static constexpr bool PERM = true, AFTER_DRAIN = false, HAS_INIT = false, FUSED_NEXT = false;
    bf16_t* O; int ldc; int row_off;
    __device__ __forceinline__ void operator()(const f32x4 (&acc)[2][2][4][2], const Unit& u, int wr, int wc, int fr, int fq) const {
        const int row0 = row_off + u.pm * BM + wr * 64 + fr; const int col0 = u.pn * BM + wc * 32 + 8 * fq;
        bf16_t* tb = O + ((size_t)(u.pm * (ldc >> 6) + u.pn * 4 + (wc >> 1)) * 256 + wr * 64 + fr) * 64 + (wc & 1) * 32 + 8 * fq;
#pragma unroll
        for (int ai = 0; ai < 2; ++ai)
#pragma unroll
            for (int m = 0; m < 4; ++m) { bf16_t* rowp = TILED ? tb + (size_t)(ai * HALF + m * 16) * 64 : O + (size_t)(row0 + ai * HALF + m * 16) * ldc + col0;
#pragma unroll
                for (int bj = 0; bj < 2; ++bj) { f32x4 v0 = acc[ai][bj][m][0], v1 = acc[ai][bj][m][1];
                    if (ACT == 1) {
#pragma unroll
                        for (int j = 0; j < 4; ++j) { const float a = fmaxf(v0[j], 0.f), b = fmaxf(v1[j], 0.f); v0[j] = a * a; v1[j] = b * b; } }
                    u32x4 w; w.x = cvt_pk_bf16(v0[0], v0[1]); w.y = cvt_pk_bf16(v0[2], v0[3]); w.z = cvt_pk_bf16(v1[0], v1[1]); w.w = cvt_pk_bf16(v1[2], v1[3]);
                    *(u32x4*)(rowp + (TILED ? bj * 2 * 256 * 64 : bj * HALF)) = w; } }
    }
};
struct EpiResF32 {
    static constexpr bool PERM = false, AFTER_DRAIN = false, HAS_INIT = true, FUSED_NEXT = false;
    float* out; int ldc; const float* ssq; int live; const bf16_t* xb;
    __device__ __forceinline__ void init(f32x4 (&acc)[2][2][4][2], const Unit& u, int wr, int wc, int fr, int fq) const {
        typedef unsigned u32x2v __attribute__((ext_vector_type(2)));
        const int r0 = wr * 64 + fr; const float* sp = ssq + u.pm * BM;
        const bf16_t* xt = xb + ((size_t)(u.pm * (ldc >> 6) + u.pn * 4 + (wc >> 1)) * 256 + r0) * 64 + (wc & 1) * 32 + 4 * fq;
#pragma unroll
        for (int ai = 0; ai < 2; ++ai)
#pragma unroll
            for (int m = 0; m < 4; ++m) { const int r = r0 + ai * HALF + m * 16; const float iv = sp[r] * (1.f / 4096.f) + 1e-6f;
#pragma unroll
                for (int bj = 0; bj < 2; ++bj)
#pragma unroll
                    for (int n = 0; n < 2; ++n) { const u32x2v w = *(const u32x2v*)(xt + (size_t)(ai * HALF + m * 16) * 64 + (size_t)bj * 2 * 256 * 64 + n * 16);
                        acc[ai][bj][m][n] = (f32x4){__uint_as_float(w.x << 16), __uint_as_float(w.x & 0xffff0000u), __uint_as_float(w.y << 16), __uint_as_float(w.y & 0xffff0000u)} * iv; } }
    }
    __device__ __forceinline__ void operator()(const f32x4 (&acc)[2][2][4][2], const Unit& u, int wr, int wc, int fr, int fq) const {
        const int r0 = wr * 64 + fr, col0 = u.pn * BM + wc * 32 + 4 * fq;
        float* op = out + (size_t)u.pm * BM * ldc; const float* sp = ssq + u.pm * BM;
        float rs[8];
#pragma unroll
        for (int gi = 0; gi < 8; ++gi) rs[gi] = sp[r0 + (gi >> 2) * HALF + (gi & 3) * 16];
#pragma unroll
        for (int gi = 0; gi < 8; ++gi) rs[gi] = __builtin_amdgcn_rcpf(rs[gi] * (1.f / 4096.f) + 1e-6f);
        if (live)
#pragma unroll
        for (int gi = 0; gi < 8; ++gi) { const int ai = gi >> 2, m = gi & 3; float* q = op + (size_t)(r0 + ai * HALF + m * 16) * ldc + col0;
#pragma unroll
            for (int bj = 0; bj < 2; ++bj)
#pragma unroll
                for (int n = 0; n < 2; ++n) *(f32x4*)(q + bj * HALF + n * 16) = acc[ai][bj][m][n] * rs[gi]; }
    }
};
struct EpiProjNorm {
    static constexpr bool PERM = true, AFTER_DRAIN = false, HAS_INIT = false, FUSED_NEXT = false;
    bf16_t* O; int ldc; PG8_LAS float* xl; const PG8_LAS float* gl;
    __device__ __forceinline__ void operator()(const f32x4 (&acc)[2][2][4][2], const Unit& u, int wr, int wc, int fr_, int fq_) const {
        const int ln = lane_id(), fr = ln & 15, fq = ln >> 4; (void)fr_; (void)fq_;
        const int row0 = u.pm * BM + wr * 64 + fr; const int col0 = u.pn * BM + wc * 32 + 8 * fq;
        const int pn = u.pn;
        const int gsel = pn < 8 ? 0 : (pn < 16 ? 1 : ((pn >= 24 && pn < 32) ? 2 : ((pn >= 32 && pn < 34) ? 3 : -1)));
        if (gsel < 0) {
#pragma unroll
            for (int ai = 0; ai < 2; ++ai)
#pragma unroll
                for (int m = 0; m < 4; ++m) { bf16_t* rowp = O + (size_t)(row0 + ai * HALF + m * 16) * ldc + col0;
#pragma unroll
                    for (int bj = 0; bj < 2; ++bj) { const f32x4 v0 = acc[ai][bj][m][0] * F6_DESCALE, v1 = acc[ai][bj][m][1] * F6_DESCALE;
                        u32x4 w; w.x = cvt_pk_bf16(v0[0], v0[1]); w.y = cvt_pk_bf16(v0[2], v0[3]); w.z = cvt_pk_bf16(v1[0], v1[1]); w.w = cvt_pk_bf16(v1[2], v1[3]);
                        *(u32x4*)(rowp + bj * HALF) = w; } }
        } else {
#pragma unroll
            for (int ai = 0; ai < 2; ++ai)
#pragma unroll
                for (int m = 0; m < 4; ++m)
#pragma unroll
                    for (int bj = 0; bj < 2; ++bj) { const f32x4 a = acc[ai][bj][m][0], b = acc[ai][bj][m][1];
                        float s = (a[0] * a[0] + a[1] * a[1]) + (a[2] * a[2] + a[3] * a[3]) + (b[0] * b[0] + b[1] * b[1]) + (b[2] * b[2] + b[3] * b[3]);
                        { unsigned sa = __builtin_bit_cast(unsigned, s), sb = sa; asm volatile("" : "+v"(sb)); auto rr = __builtin_amdgcn_permlane16_swap(sa, sb, false, false); unsigned r0 = rr[0], r1 = rr[1]; asm volatile("" : "+v"(r0), "+v"(r1)); s = __builtin_bit_cast(float, r0) + __builtin_bit_cast(float, r1); }
                        { unsigned sa = __builtin_bit_cast(unsigned, s), sb = sa; asm volatile("" : "+v"(sb)); auto rr = __builtin_amdgcn_permlane32_swap(sa, sb, false, false); unsigned r0 = rr[0], r1 = rr[1]; asm volatile("" : "+v"(r0), "+v"(r1)); s = __builtin_bit_cast(float, r0) + __builtin_bit_cast(float, r1); }
                        if (fq == 0) xl[((ai * HALF + wr * 64 + m * 16 + fr) * 2 + bj) * 4 + wc] = s; }
            asm volatile("s_waitcnt lgkmcnt(0)" ::: "memory"); __builtin_amdgcn_s_barrier(); asm volatile("" ::: "memory");
            const PG8_LAS float* gp = gl + gsel * 128 + wc * 32 + 8 * fq;
            const f32x4 g0 = *(const PG8_LAS f32x4*)gp, g1 = *(const PG8_LAS f32x4*)(gp + 4);
#pragma unroll
            for (int ai = 0; ai < 2; ++ai)
#pragma unroll
                for (int m = 0; m < 4; ++m) { bf16_t* rowp = O + (size_t)(row0 + ai * HALF + m * 16) * ldc + col0;
#pragma unroll
                    for (int bj = 0; bj < 2; ++bj) { const f32x4 p = *(const PG8_LAS f32x4*)(xl + ((ai * HALF + wr * 64 + m * 16 + fr) * 2 + bj) * 4);
                        const float rstd = __builtin_amdgcn_rsqf(((p[0] + p[1]) + (p[2] + p[3])) * (F6_DESCALE * F6_DESCALE / 128.f) + 1e-6f) * F6_DESCALE;
                        const f32x4 v0 = acc[ai][bj][m][0] * rstd * g0, v1 = acc[ai][bj][m][1] * rstd * g1;
                        u32x4 w; w.x = cvt_pk_bf16(v0[0], v0[1]); w.y = cvt_pk_bf16(v0[2], v0[3]); w.z = cvt_pk_bf16(v1[0], v1[1]); w.w = cvt_pk_bf16(v1[2], v1[3]);
                        *(u32x4*)(rowp + bj * HALF) = w; } }
            asm volatile("s_waitcnt lgkmcnt(0)" ::: "memory"); __builtin_amdgcn_s_barrier(); asm volatile("" ::: "memory");
        }
    }
};
struct EpiResStats {
    static constexpr bool PERM = false, AFTER_DRAIN = false, HAS_INIT = true, FUSED_NEXT = true;
    const float* base0; const float* base1; int split; float* out; bf16_t* xb; float* ssq; int ldc; int live;
    __device__ __forceinline__ void init(f32x4 (&acc)[2][2][4][2], const Unit& u, int wr, int wc, int fr_, int fq_) const {
        const int ln = lane_id(), fr = ln & 15, fq = ln >> 4; (void)fr_; (void)fq_;
        const int r0 = wr * 64 + fr, col0 = u.pn * BM + wc * 32 + 4 * fq;
        const float* bp = (u.pm < split) ? base0 + (size_t)u.pm * BM * ldc : base1 + (size_t)(u.pm - split) * BM * ldc;
#pragma unroll
        for (int ai = 0; ai < 2; ++ai)
#pragma unroll
            for (int m = 0; m < 4; ++m) { const float* p = bp + (size_t)(r0 + ai * HALF + m * 16) * ldc + col0;
#pragma unroll
                for (int bj = 0; bj < 2; ++bj)
#pragma unroll
                    for (int n = 0; n < 2; ++n) acc[ai][bj][m][n] = *(const f32x4*)(p + bj * HALF + n * 16) * (1.0f / F8_DESCALE); }
    }
    __device__ __forceinline__ void scale(f32x4 (&acc)[2][2][4][2]) const {
#pragma unroll
        for (int ai = 0; ai < 2; ++ai)
#pragma unroll
            for (int bj = 0; bj < 2; ++bj)
#pragma unroll
                for (int m = 0; m < 4; ++m)
#pragma unroll
                    for (int n = 0; n < 2; ++n) acc[ai][bj][m][n] *= (1.0f / F8_DESCALE);
    }
    __device__ __forceinline__ void fused(f32x4 (&acc)[2][2][4][2], const Unit& u, const Unit& nx, const bool has_next, int wr, int wc) const {
        typedef unsigned u32x2v __attribute__((ext_vector_type(2)));
        const int ln = lane_id(), fr = ln & 15, fq = ln >> 4;
        const int r0 = wr * 64 + fr, col0 = u.pn * BM + wc * 32 + 4 * fq;
        const float* bpn = (nx.pm < split) ? base0 + (size_t)nx.pm * BM * ldc : base1 + (size_t)(nx.pm - split) * BM * ldc;
        const int col0n = nx.pn * BM + wc * 32 + 4 * fq;
        float* sp = ssq + u.pm * BM;
        bf16_t* xt = xb + ((size_t)(u.pm * (ldc >> 6) + u.pn * 4 + (wc >> 1)) * 256 + r0) * 64 + (wc & 1) * 32 + 4 * fq;
        if (live)
#pragma unroll
        for (int ai = 0; ai < 2; ++ai)
#pragma unroll
            for (int m = 0; m < 4; ++m) { const int r = r0 + ai * HALF + m * 16;
                float s = 0.f;
#pragma unroll
                for (int bj = 0; bj < 2; ++bj)
#pragma unroll
                    for (int n = 0; n < 2; ++n) { const f32x4 v = acc[ai][bj][m][n] * F8_DESCALE;
                        u32x2v w; w.x = cvt_pk_bf16(v[0], v[1]); w.y = cvt_pk_bf16(v[2], v[3]); *(u32x2v*)(xt + (size_t)(ai * HALF + m * 16) * 64 + (size_t)bj * 2 * 256 * 64 + n * 16) = w;
                        s += (v[0] * v[0] + v[1] * v[1]) + (v[2] * v[2] + v[3] * v[3]); }
                { unsigned sa = __builtin_bit_cast(unsigned, s), sb = sa; asm volatile("" : "+v"(sb)); auto rr = __builtin_amdgcn_permlane16_swap(sa, sb, false, false); unsigned r0 = rr[0], r1 = rr[1]; asm volatile("" : "+v"(r0), "+v"(r1)); s = __builtin_bit_cast(float, r0) + __builtin_bit_cast(float, r1); }
                { unsigned sa = __builtin_bit_cast(unsigned, s), sb = sa; asm volatile("" : "+v"(sb)); auto rr = __builtin_amdgcn_permlane32_swap(sa, sb, false, false); unsigned r0 = rr[0], r1 = rr[1]; asm volatile("" : "+v"(r0), "+v"(r1)); s = __builtin_bit_cast(float, r0) + __builtin_bit_cast(float, r1); }
                if (fq == 0) __hip_atomic_fetch_add(sp + r, s, __ATOMIC_RELAXED, __HIP_MEMORY_SCOPE_AGENT);
                if (has_next) { const float* p = bpn + (size_t)(r0 + ai * HALF + m * 16) * ldc + col0n;
#pragma unroll
                    for (int bj = 0; bj < 2; ++bj)
#pragma unroll
                        for (int n = 0; n < 2; ++n) acc[ai][bj][m][n] = *(const f32x4*)(p + bj * HALF + n * 16); } }
    }
};

typedef int v8i_t __attribute__((ext_vector_type(8)));
typedef int v4i_t __attribute__((ext_vector_type(4)));
template <bool F8> struct Frag;
template <> struct Frag<false> { v4i_t v[2]; };
template <> struct Frag<true> { v8i_t v; };
template <bool F8> __device__ __forceinline__ void fset(Frag<F8>& f, int k, v4i_t x) { if constexpr (F8) { if (k == 0) f.v.lo = x; else f.v.hi = x; } else f.v[k] = x; }
template <int MODE> __device__ __forceinline__ f32x4 fmma(const Frag<(MODE != 0)>& b, const Frag<(MODE != 0)>& a, f32x4 c) {
    if constexpr (MODE == 1) return __builtin_amdgcn_mfma_scale_f32_16x16x128_f8f6f4(b.v, a.v, c, 0, 0, 0, 0, 0, 0);
    else if constexpr (MODE == 3) return __builtin_amdgcn_mfma_scale_f32_16x16x128_f8f6f4(b.v, a.v, c, 2, 2, 0, 0, 0, 0);
    else { c = __builtin_amdgcn_mfma_f32_16x16x32_bf16(__builtin_bit_cast(bf16x8, b.v[0]), __builtin_bit_cast(bf16x8, a.v[0]), c, 0, 0, 0); return __builtin_amdgcn_mfma_f32_16x16x32_bf16(__builtin_bit_cast(bf16x8, b.v[1]), __builtin_bit_cast(bf16x8, a.v[1]), c, 0, 0, 0); }
}
template <class Epi, class Sched, bool ALIGN_EPI = false, bool SP2 = false, int MODE = 0>
__device__ __forceinline__ void gemm_phase(PG8_LAS unsigned char* lds, const Gemm g, const Sched& S, const Epi& E, const int wave  ) {
    const int lane = lane_id(), wid = wave, tid = wave * 64 + lane, wr = wid >> 2, wc = wid & 3, fr = lane & 15, fq = lane >> 4;
    const int K = g.K, nt = K / BK;
    unsigned voffA[2], voffB[2];
#pragma unroll
    for (int i = 0; i < 2; ++i) { int R, C; stage_rc(tid * 16 + i * 8192, R, C); const int Rb = Epi::PERM ? ((R & ~31) + perm32(R & 31)) : R;
        voffA[i] = (unsigned)(R * g.lda + C) * 2u; voffB[i] = (unsigned)(Rb * g.ldb + C) * 2u; }
    const size_t kstepA = g.ksa, kstepB = g.ksb;
    const size_t hstepA = (size_t)HALF * g.lda * 2, hstepB = (size_t)HALF * g.ldb * 2;
    const size_t tstepA = g.tsa, tstepB = g.tsb;
    const unsigned ldsa = (unsigned)__builtin_amdgcn_readfirstlane((int)((unsigned)(size_t)lds + (unsigned)wid * 1024u));
    const int aoff = lds_byte(wr * 64 + fr, fq * 8), boff = lds_byte(wc * 32 + fr, fq * 8);
#define PG8_SA(b, h) (((b) * 2 + (h)) * HTB)
#define PG8_SB(b, h) ((4 + (b) * 2 + (h)) * HTB)
#define PG8_STAGE(bufoff, gbase, voff) do { _Pragma("unroll") for (int _i = 0; _i < 2; ++_i) pg8::glds16((const char*)(gbase), (voff)[_i], ldsa + (unsigned)((bufoff) + _i * 8192)); } while (0)
#define PG8_LDA(dst, b, h) do { _Pragma("unroll") for (int m = 0; m < 4; ++m) _Pragma("unroll") for (int k = 0; k < 2; ++k) pg8::fset<(MODE != 0)>(dst[m], k, *(const PG8_LAS v4i_t*)(lds + PG8_SA(b, h) + aoff + m * 2048 + k * 1024)); } while (0)
#define PG8_LDB(dst, b, h) do { _Pragma("unroll") for (int n = 0; n < 2; ++n) _Pragma("unroll") for (int k = 0; k < 2; ++k) pg8::fset<(MODE != 0)>(dst[n], k, *(const PG8_LAS v4i_t*)(lds + PG8_SB(b, h) + boff + n * 2048 + k * 1024)); } while (0)
#define PG8_MMA(ai, bj, At, Bt) do { __builtin_amdgcn_s_setprio(1); _Pragma("unroll") for (int m = 0; m < 4; ++m) _Pragma("unroll") for (int n = 0; n < 2; ++n) acc[ai][bj][m][n] = pg8::fmma<MODE>(Bt[n], At[m], acc[ai][bj][m][n]); __builtin_amdgcn_s_setprio(0); } while (0)
#define PG8_WAIT_V(n) asm volatile("s_waitcnt vmcnt(" #n ")" ::: "memory")
#define PG8_WAIT_L(n) asm volatile("s_waitcnt lgkmcnt(" #n ")" ::: "memory")
#define PG8_BAR __builtin_amdgcn_s_barrier()
#define PG8_SCHED __builtin_amdgcn_sched_barrier(0)
    Unit cur, nxt; int ui = 0;
    if (!S.next(0, cur)) return;
    f32x4 acc[2][2][4][2];
    if constexpr (Epi::HAS_INIT) E.init(acc, cur, wr, wc, fr, fq);
    else {
#pragma unroll
    for (int a = 0; a < 2; ++a)
#pragma unroll
        for (int b = 0; b < 2; ++b)
#pragma unroll
            for (int m = 0; m < 4; ++m)
#pragma unroll
                for (int n = 0; n < 2; ++n) acc[a][b][m][n] = (f32x4){0.f, 0.f, 0.f, 0.f};
    }
    Frag<(MODE != 0)> At[4], B0[2], B1[2];
    const char* cA = (const char*)g.A + (size_t)cur.pm * tstepA; const char* cB = (const char*)g.Bt + (size_t)cur.pn * tstepB;
    S.a_ready(cur);
    if constexpr (SP2) {
        PG8_STAGE(PG8_SB(0, 0), cB, voffB); PG8_STAGE(PG8_SB(0, 1), cB + hstepB, voffB); PG8_STAGE(PG8_SA(0, 0), cA, voffA); PG8_STAGE(PG8_SA(0, 1), cA + hstepA, voffA);
        if (wr == 1) PG8_BAR;
        PG8_WAIT_V(2); PG8_BAR;
        PG8_STAGE(PG8_SB(1, 0), cB + kstepB, voffB); PG8_STAGE(PG8_SA(1, 0), cA + kstepA, voffA); PG8_STAGE(PG8_SB(1, 1), cB + hstepB + kstepB, voffB);
        PG8_WAIT_V(6); PG8_BAR;
    } else {
        PG8_STAGE(PG8_SB(0, 0), cB, voffB); PG8_STAGE(PG8_SA(0, 0), cA, voffA); PG8_STAGE(PG8_SB(0, 1), cB + hstepB, voffB); PG8_STAGE(PG8_SA(0, 1), cA + hstepA, voffA);
        if (wr == 1) PG8_BAR;
        PG8_WAIT_V(4); PG8_BAR;
        PG8_STAGE(PG8_SB(1, 0), cB + kstepB, voffB); PG8_STAGE(PG8_SA(1, 0), cA + kstepA, voffA); PG8_STAGE(PG8_SB(1, 1), cB + hstepB + kstepB, voffB);
        PG8_WAIT_V(6); PG8_BAR;
    }
    for (;;) {
        const bool has_next = S.next(ui + 1, nxt);
        const char* nA = has_next ? (const char*)g.A + (size_t)nxt.pm * tstepA : cA; const char* nB = has_next ? (const char*)g.Bt + (size_t)nxt.pn * tstepB : cB;
        for (int t = 0; t < nt; t += 2) {
            const bool last = (t == nt - 2);
            const char* a1 = cA + (size_t)(t + 1) * kstepA;
            const char* a2 = last ? nA : cA + (size_t)(t + 2) * kstepA; const char* b2 = last ? nB : cB + (size_t)(t + 2) * kstepB;
            const char* a3 = a2 + kstepA; const char* b3 = b2 + kstepB;
            if (last && has_next) S.a_ready(nxt);
            if constexpr (SP2) {
            PG8_LDB(B0, 0, 0); PG8_LDB(B1, 0, 1); PG8_SCHED; PG8_LDA(At, 0, 0); PG8_STAGE(PG8_SA(1, 1), a1 + hstepA, voffA);
            PG8_WAIT_V(8); PG8_WAIT_L(0); PG8_BAR; PG8_MMA(0, 0, At, B0); PG8_MMA(0, 1, At, B1); PG8_BAR; PG8_SCHED;
            PG8_LDA(At, 0, 1); PG8_STAGE(PG8_SB(0, 0), b2, voffB); PG8_STAGE(PG8_SB(0, 1), b2 + hstepB, voffB); PG8_STAGE(PG8_SA(0, 0), a2, voffA);
            PG8_WAIT_V(8); PG8_WAIT_L(0); PG8_BAR; PG8_MMA(1, 0, At, B0); PG8_MMA(1, 1, At, B1); PG8_BAR; PG8_SCHED;
            PG8_LDB(B0, 1, 0); PG8_LDB(B1, 1, 1); PG8_SCHED; PG8_LDA(At, 1, 0); PG8_STAGE(PG8_SA(0, 1), a2 + hstepA, voffA);
            PG8_WAIT_V(8); PG8_WAIT_L(0); PG8_BAR; PG8_MMA(0, 0, At, B0); PG8_MMA(0, 1, At, B1); PG8_BAR; PG8_SCHED;
            PG8_LDA(At, 1, 1); PG8_STAGE(PG8_SB(1, 0), b3, voffB); PG8_STAGE(PG8_SB(1, 1), b3 + hstepB, voffB); PG8_STAGE(PG8_SA(1, 0), a3, voffA);
            PG8_WAIT_V(8); PG8_WAIT_L(0); PG8_BAR; PG8_MMA(1, 0, At, B0); PG8_MMA(1, 1, At, B1); PG8_BAR; PG8_SCHED;
            } else {
            PG8_LDB(B0, 0, 0); PG8_SCHED; PG8_LDA(At, 0, 0); PG8_STAGE(PG8_SA(1, 1), a1 + hstepA, voffA);
            PG8_WAIT_L(8); PG8_BAR; PG8_WAIT_L(0); PG8_MMA(0, 0, At, B0); PG8_BAR; PG8_SCHED;
            PG8_LDB(B1, 0, 1); PG8_STAGE(PG8_SB(0, 0), b2, voffB);
            PG8_BAR; PG8_WAIT_L(0); PG8_MMA(0, 1, At, B1); PG8_BAR;
            PG8_LDA(At, 0, 1); PG8_STAGE(PG8_SA(0, 0), a2, voffA);
            PG8_BAR; PG8_WAIT_L(0); PG8_MMA(1, 0, At, B0); PG8_BAR; PG8_SCHED;
            PG8_STAGE(PG8_SB(0, 1), b2 + hstepB, voffB);
            PG8_WAIT_V(6); PG8_BAR; PG8_MMA(1, 1, At, B1); PG8_BAR;
            PG8_LDB(B0, 1, 0); PG8_SCHED; PG8_LDA(At, 1, 0); PG8_STAGE(PG8_SA(0, 1), a2 + hstepA, voffA);
            PG8_WAIT_L(8); PG8_BAR; PG8_WAIT_L(0); PG8_MMA(0, 0, At, B0); PG8_BAR; PG8_SCHED;
            PG8_LDB(B1, 1, 1); PG8_STAGE(PG8_SB(1, 0), b3, voffB);
            PG8_BAR; PG8_WAIT_L(0); PG8_MMA(0, 1, At, B1); PG8_BAR;
            PG8_LDA(At, 1, 1); PG8_STAGE(PG8_SA(1, 0), a3, voffA);
            PG8_BAR; PG8_WAIT_L(0); PG8_MMA(1, 0, At, B0); PG8_BAR; PG8_SCHED;
            PG8_STAGE(PG8_SB(1, 1), b3 + hstepB, voffB);
            PG8_WAIT_V(6); PG8_BAR; PG8_MMA(1, 1, At, B1); PG8_BAR;
            }
        }
        if constexpr (ALIGN_EPI) { if (wr == 0) PG8_BAR; }
        if constexpr (Epi::FUSED_NEXT) { E.fused(acc, cur, nxt, has_next, wr, wc); S.done(cur); }
        else if constexpr (!Epi::AFTER_DRAIN) { E(acc, cur, wr, wc, fr, fq); S.done(cur); }
        if (!has_next) break;
        if constexpr (Epi::FUSED_NEXT) E.scale(acc);
        else if constexpr (Epi::HAS_INIT) E.init(acc, nxt, wr, wc, fr, fq);
        else {
#pragma unroll
        for (int a = 0; a < 2; ++a)
#pragma unroll
            for (int b = 0; b < 2; ++b)
#pragma unroll
                for (int m = 0; m < 4; ++m)
#pragma unroll
                    for (int n = 0; n < 2; ++n) acc[a][b][m][n] = (f32x4){0.f, 0.f, 0.f, 0.f};
        }
        cur = nxt; cA = nA; cB = nB; ++ui;
        if constexpr (ALIGN_EPI) { if (wr == 1) PG8_BAR; }
    }
    PG8_WAIT_V(0);
    if constexpr (!ALIGN_EPI) { if (wr == 0) PG8_BAR; }
    PG8_BAR;
    if constexpr (Epi::AFTER_DRAIN) { E.fused(acc, cur, wr, wc, fr, fq, lds, wid, lane); S.done(cur); }
#undef PG8_SA
#undef PG8_SB
#undef PG8_STAGE
#undef PG8_LDA
#undef PG8_LDB
#undef PG8_MMA
#undef PG8_WAIT_V
#undef PG8_WAIT_L
#undef PG8_BAR
#undef PG8_SCHED
}
}
#define GAS __attribute__((address_space(1)))
#define LAS __attribute__((address_space(3)))
typedef unsigned short bf16;
typedef unsigned v4u __attribute__((ext_vector_type(4)));
typedef float f32x4 __attribute__((ext_vector_type(4)));
typedef short bf16x8 __attribute__((ext_vector_type(8)));
typedef GAS unsigned gu32;
typedef GAS unsigned long long gu64;
#define RLX_AGENT __ATOMIC_RELAXED, __HIP_MEMORY_SCOPE_AGENT
#define LDS_WAIT() asm volatile("s_waitcnt lgkmcnt(0)" ::: "memory")
#define VM_WAIT() asm volatile("s_waitcnt vmcnt(0)" ::: "memory")
__device__ __forceinline__ unsigned long long rt() { return __builtin_amdgcn_s_memrealtime(); }
__device__ __forceinline__ unsigned f2bf(float f) { unsigned u = __builtin_bit_cast(unsigned, f); return (u + 0x7fffu + ((u >> 16) & 1u)) >> 16; }
__device__ __forceinline__ unsigned pk2(float lo, float hi) { return f2bf(lo) | (f2bf(hi) << 16); }
#ifndef WDROP_MLP
#define WDROP_MLP 1
#endif
__device__ __forceinline__ unsigned f2bfw(float f, int drop) { const int S = 16 + drop; unsigned u = __builtin_bit_cast(unsigned, f); return ((u + ((1u << (S - 1)) - 1u) + ((u >> S) & 1u)) >> S) << drop; }
__device__ __forceinline__ unsigned pk2w(float lo, float hi, int drop) { return f2bfw(lo, drop) | (f2bfw(hi, drop) << 16); }

#define XB_TMO      128
#define XB_XCNT(j)  (256  + 64 * (j))
#define XB_XSUB(j)  (1280 + 64 * (j))
#define XB_XGEN(j)  (2304 + 64 * (j))
#define XB_TOP      3328
#define XB_TOPGEN   3392
#define XCD_BAR_WORDS 3456
#define XB_SPIN_CAP (1u << 18)

__device__ __forceinline__ unsigned xb_ld(unsigned* p)              { return __hip_atomic_load(p, __ATOMIC_RELAXED, __HIP_MEMORY_SCOPE_AGENT); }
__device__ __forceinline__ unsigned xb_add(unsigned* p, unsigned v) { return __hip_atomic_fetch_add(p, v, __ATOMIC_RELAXED, __HIP_MEMORY_SCOPE_AGENT); }
__device__ __forceinline__ unsigned xb_xcc_id() { return (unsigned)__builtin_amdgcn_s_getreg((3 << 11) | 20) & 0xFu; }
#define XB_SPIN(cond, bar) do { unsigned _sp = 0; while (cond) { __builtin_amdgcn_s_sleep(1); \
    if ((++_sp & 255u) == 0u) { if (xb_ld(&(bar)[XB_TMO])) break; if (_sp > XB_SPIN_CAP) { atomicAdd(&(bar)[XB_TMO], 1u); break; } } } } while (0)

struct XcdBarrier {
    unsigned w0;
    unsigned* bar; unsigned x;
    volatile LAS unsigned* st;
};

__device__ __forceinline__ XcdBarrier xcd_barrier_post(unsigned* bar, volatile LAS unsigned* st) {
    XcdBarrier b; b.bar = bar; b.x = xb_xcc_id(); b.st = st; b.w0 = (__builtin_amdgcn_readfirstlane(threadIdx.x >> 6) == 0) ? 1u : 0u;
    if (threadIdx.x == 0) (void)xb_add(&bar[XB_XCNT(b.x)], 1u);
    return b;
}
__device__ __forceinline__ void xcd_barrier_complete(unsigned* bar, unsigned x, unsigned& nloc, unsigned& nx) {
    const unsigned G = gridDim.x * gridDim.y * gridDim.z;
    unsigned sum, cnt, mine, sp = 0u;
    for (;;) {
        sum = 0u; cnt = 0u; mine = 0u;
#pragma unroll
        for (unsigned j = 0; j < 16; ++j) { const unsigned c = xb_ld(&bar[XB_XCNT(j)]); sum += c; cnt += (c > 0u) ? 1u : 0u; mine = (j == x) ? c : mine; }
        if (sum == G) break;
        __builtin_amdgcn_s_sleep(1);
        if ((++sp & 255u) == 0u) { if (xb_ld(&bar[XB_TMO])) break; if (sp > XB_SPIN_CAP) { atomicAdd(&bar[XB_TMO], 1u); break; } }
    }
    nloc = mine > 0u ? mine : 1u; nx = cnt > 0u ? cnt : 1u;
}

__device__ __forceinline__ void xcd_barrier(const XcdBarrier& b) {
    asm volatile("s_waitcnt vmcnt(0)" ::: "memory");
    __syncthreads();
    if (b.w0 && pg8::lane_id() == 0) {
        unsigned* bar = b.bar;
        __builtin_amdgcn_s_waitcnt(0);
        unsigned nloc = b.st[0], nx = b.st[1];
        if (nloc == 0u) { xcd_barrier_complete(bar, b.x, nloc, nx); b.st[0] = nloc; b.st[1] = nx; }
        const unsigned old = xb_add(&bar[XB_XSUB(b.x)], 1u);
        const unsigned gen = old / nloc;
        if (old + 1u == (gen + 1u) * nloc) {
            __builtin_amdgcn_fence(__ATOMIC_RELEASE, "agent");
            asm volatile("s_waitcnt vmcnt(0)" ::: "memory");
            const unsigned og = xb_add(&bar[XB_TOP], 1u);
            const unsigned tg = og / nx;
            if (og + 1u == (tg + 1u) * nx) xb_add(&bar[XB_TOPGEN], 1u);
            else XB_SPIN(xb_ld(&bar[XB_TOPGEN]) == tg, bar);
            __builtin_amdgcn_fence(__ATOMIC_ACQUIRE, "agent");
            xb_add(&bar[XB_XGEN(b.x)], 1u);
            asm volatile("s_waitcnt vmcnt(0)" ::: "memory");
        } else {
            XB_SPIN(xb_ld(&bar[XB_XGEN(b.x)]) == gen, bar);
            __builtin_amdgcn_fence(__ATOMIC_ACQUIRE, "agent");
            asm volatile("s_waitcnt vmcnt(0)" ::: "memory");
        }
    }
    __syncthreads();
}

constexpr int NWAVES = 8;
#ifndef REP_P0
#ifndef P0X
#define P0X 7
#endif
#define REP_P0 1
#endif
#ifndef REP_INPROJ
#define REP_INPROJ 1
#endif
#ifndef REP_DOWN
#define REP_DOWN 1
#endif
#ifndef REP_OUT
#define REP_OUT 1
#endif
#ifndef REP_UP
#define REP_UP 1
#endif
#ifndef DOWN_WGM
#define DOWN_WGM 0
#endif
#ifndef ATT_REPS
#define ATT_REPS 1
#endif
#ifndef MK_SPLIT
#define MK_SPLIT 0
#endif
constexpr int DM = 4096, TP = 8192, TS = 2048, NSB = 8, NTOK = TP + NSB * TS, NMETA = 16, MPAD = NTOK + 256, INW = 9216, FF = 16384;
constexpr int META_ROW0 = NTOK;
constexpr int C_QNA = 0, C_KNA = 2048, C_VNA = 4096, C_QSW = 6144, C_KSW = 8192, C_VSW = 8704;
#ifndef MLP_NCH
#define MLP_NCH 3
#endif
constexpr int NCH = MLP_NCH, MHALF = NTOK / NCH;
static_assert(NTOK % (NCH * 256) == 0, "MLP chunking");
constexpr int FFP = FF;
constexpr float NORM_EPS = 1e-6f;
constexpr size_t MiB = 1u << 20;
constexpr size_t WS_CTL = 0, CTL_ZERO_BYTES = 1 * MiB;
constexpr size_t WS_WUP = 1 * MiB;
constexpr size_t WS_WDN = WS_WUP + (size_t)FF * DM * 2;
constexpr size_t WS_WOUT = WS_WDN + (size_t)FFP * DM * 2;
constexpr size_t WS_WIN = WS_WOUT + (size_t)DM * DM * 2;
constexpr size_t WS_XN = WS_WIN + (size_t)INW * DM * 2;
constexpr size_t WS_PROJ = WS_XN + (size_t)MPAD * DM * 2;
constexpr size_t WS_END = WS_PROJ + (size_t)MPAD * INW * 2;
constexpr size_t WS_ATT = WS_XN;
constexpr size_t WS_U = WS_WOUT;
constexpr size_t WS_H2 = (WS_U + (size_t)MHALF * FFP * 2 > WS_PROJ) ? WS_U + (size_t)MHALF * FFP * 2 : WS_PROJ;
static_assert(WS_H2 >= WS_PROJ && WS_H2 + (size_t)NTOK * DM * 2 <= WS_END, "H2 placement");
constexpr int CW_BAR = 4096;
constexpr int CW_SSQ = 65536;
static_assert((CW_SSQ + NTOK) * 4 <= (int)CTL_ZERO_BYTES, "ssq inside the memset region");
constexpr int RING_OFF = 0, RING_BYTES = 131072;
constexpr int LDSCTL_OFF = RING_BYTES, MISC_OFF = LDSCTL_OFF + 320;
constexpr int XL_OFF = MISC_OFF + 128, GL_OFF = XL_OFF + 8192;
constexpr int LDS_BYTES = 147456;
static_assert(GL_OFF + 2048 <= LDS_BYTES && (XL_OFF % 16) == 0, "LDS map");

struct Args { const float* in[16]; float* out; unsigned char* ws; int ph_lo, ph_hi, rep_p0, rep_inproj, li, rep_up, rep_out, pad; };
struct Frame {
    LAS unsigned char* lds;
    volatile LAS unsigned* MISC;
    gu32* ctl;
    int wave;
    int vcu, G;
};

__device__ __forceinline__ float wave_sum(float v) {
#pragma unroll
    for (int o = 1; o < 64; o <<= 1) v += __shfl_xor(v, o);
    return v;
}
__device__ __forceinline__ float wave_max(float v) {
#pragma unroll
    for (int o = 1; o < 64; o <<= 1) v = fmaxf(v, __shfl_xor(v, o));
    return v;
}
__device__ __forceinline__ float bf_lo(unsigned w) { return __uint_as_float(w << 16); }
__device__ __forceinline__ float bf_hi(unsigned w) { return __uint_as_float(w & 0xffff0000u); }

__device__ __forceinline__ void p0_transpose_item(const float* W, int K, int N, bf16* WT, LAS float* scr, int item, int lane, int drop, const float* gk = nullptr, int ldt = 0) {
    if (ldt == 0) ldt = K;
    const int nblk = N / 32, kb = item / nblk, nb = item % nblk, k0 = 64 * kb, n0 = 32 * nb;
    const int c = lane & 7;
    f32x4 g0 = {1.f, 1.f, 1.f, 1.f}, g1 = g0;
    if (gk) { g0 = *(const GAS f32x4*)(gk + k0 + 8 * c); g1 = *(const GAS f32x4*)(gk + k0 + 8 * c + 4); }
#pragma unroll
    for (int i = 0; i < 32; ++i) { const int kk = 2 * i + (lane >> 5); scr[kk * 33 + (lane & 31)] = W[(size_t)(k0 + kk) * N + n0 + (lane & 31)]; }
    LDS_WAIT(); asm volatile("" ::: "memory");
#pragma unroll
    for (int j = 0; j < 4; ++j) { const int n = (lane >> 3) + 8 * j; const LAS float* s = scr + (8 * c) * 33 + n;
        v4u o; o.x = pk2w(s[0 * 33] * g0[0], s[1 * 33] * g0[1], drop); o.y = pk2w(s[2 * 33] * g0[2], s[3 * 33] * g0[3], drop); o.z = pk2w(s[4 * 33] * g1[0], s[5 * 33] * g1[1], drop); o.w = pk2w(s[6 * 33] * g1[2], s[7 * 33] * g1[3], drop);
        *(GAS v4u*)(WT + (ldt < 0 ? ((size_t)(((n0 + n) >> 8) * (K >> 6) + kb) * 256 + ((n0 + n) & 255)) * 64 + 8 * c : (size_t)(n0 + n) * ldt + k0 + 8 * c)) = o; }
    LDS_WAIT(); asm volatile("" ::: "memory");
}
__host__ __device__ __forceinline__ size_t tiled_off(int row, int col) { return ((size_t)((row >> 8) * (DM / 64) + (col >> 6)) * 256 + (row & 255)) * 64 + (col & 63); }
typedef float v16f_t __attribute__((ext_vector_type(16)));
typedef unsigned v6u_t __attribute__((ext_vector_type(6)));
__device__ __forceinline__ void rms_row_to_f6(const float* xrow, const float* gain, unsigned char* obase, int orow, int lane) {
    const GAS f32x4* xr = (const GAS f32x4*)xrow + lane;
    f32x4 v[16]; float s = 0.f;
#pragma unroll
    for (int j = 0; j < 16; ++j) { v[j] = xr[64 * j]; s += (v[j].x * v[j].x + v[j].y * v[j].y) + (v[j].z * v[j].z + v[j].w * v[j].w); }
    const float rstd = (float)(1 << F6_SH_A) / sqrtf(wave_sum(s) * (1.f / DM) + NORM_EPS);
    const GAS f32x4* gr = (const GAS f32x4*)gain + lane;
    unsigned char* ob = obase + ((size_t)((orow >> 8) * (DM / 128) + (lane >> 1)) * 256 + (orow & 255)) * 128 + 32 * (lane & 1);
#pragma unroll
    for (int h = 0; h < 2; ++h) { v16f_t a, b;
#pragma unroll
        for (int jj = 0; jj < 4; ++jj) { const f32x4 ga = gr[64 * (8 * h + jj)], gb = gr[64 * (8 * h + 4 + jj)];
#pragma unroll
            for (int i = 0; i < 4; ++i) { a[4 * jj + i] = __builtin_amdgcn_fmed3f(v[8 * h + jj][i] * rstd * ga[i], -7.5f, 7.5f); b[4 * jj + i] = __builtin_amdgcn_fmed3f(v[8 * h + 4 + jj][i] * rstd * gb[i], -7.5f, 7.5f); } }
        const v6u_t w = __builtin_amdgcn_cvt_scalef32_2xpk16_fp6_f32(a, b, 1.0f);
        *(GAS v4u*)(ob + 16 * h) = (v4u){w[0], w[1], w[2], w[3]}; *(GAS v4u*)(ob + 16 * h + 64) = (v4u){w[4], w[5], 0u, 0u}; }
}
__device__ __forceinline__ void p0_w6_item(const float* W, int N, unsigned char* W8, LAS float* scr, int item, int lane) {
    const int nblk = N / 32, kt = item / nblk, nb = item % nblk, n0 = 32 * nb;
#pragma unroll 16
    for (int it = 0; it < 64; ++it) { const int rho = 2 * it + (lane >> 5), jj = rho >> 3, r = rho & 7, n = lane & 31;
        const int kk2 = (2 * (r >> 2) + (jj >> 3)) * 32 + 4 * (jj & 7) + (r & 3);
        scr[kk2 * 32 + (n ^ ((kk2 >> 5) << 3))] = W[(size_t)(256 * jj + 8 * kt + r) * N + n0 + n]; }
    LDS_WAIT(); asm volatile("" ::: "memory");
    const int c = lane & 3; const float sc = (float)(1 << F6_SH_B);
#pragma unroll
    for (int pass = 0; pass < 2; ++pass) { const int n = (lane >> 2) + 16 * pass; const LAS float* sp = scr + (c * 32) * 32 + (n ^ (c << 3)); v16f_t a, b;
#pragma unroll
        for (int e = 0; e < 16; ++e) { a[e] = __builtin_amdgcn_fmed3f(sp[e * 32] * sc, -7.5f, 7.5f); b[e] = __builtin_amdgcn_fmed3f(sp[(16 + e) * 32] * sc, -7.5f, 7.5f); }
        const v6u_t w = __builtin_amdgcn_cvt_scalef32_2xpk16_fp6_f32(a, b, 1.0f);
        unsigned char* dst = W8 + ((size_t)(((n0 + n) >> 8) * 32 + kt) * 256 + ((n0 + n) & 255)) * 128 + 16 * c;
        *(GAS v4u*)dst = (v4u){w[0], w[1], w[2], w[3]}; *(GAS v4u*)(dst + 64) = (v4u){w[4], w[5], 0u, 0u}; }
    LDS_WAIT(); asm volatile("" ::: "memory");
}
template <bool HEADMAP>
__device__ __forceinline__ void p0_w8_item(const float* W, int N, unsigned char* W8, LAS float* scr, int item, int lane) {
    const int nblk = N / 32, kt = item / nblk, nb = item % nblk, k0 = 128 * kt, n0 = 32 * nb;
#define W8_SWZ(kk) ((HEADMAP ? (((kk) >> 2) & 7) : (((kk) >> 4) & 7)) << 2)
#pragma unroll 16
    for (int i = 0; i < 64; ++i) { const int kk = 2 * i + (lane >> 5), n = lane & 31; scr[kk * 32 + (n ^ W8_SWZ(kk))] = W[(size_t)(k0 + kk) * N + n0 + n]; }
    LDS_WAIT(); asm volatile("" ::: "memory");
    const int c = lane & 7; const float sc = (float)(1 << F8_SH_B);
#pragma unroll
    for (int j = 0; j < 4; ++j) { const int n = (lane >> 3) + 8 * j; unsigned o4[4];
#pragma unroll
        for (int w = 0; w < 4; ++w) { float f[4];
#pragma unroll
            for (int b = 0; b < 4; ++b) { const int t = 4 * w + b; const int kk = HEADMAP ? 32 * (t & 3) + 4 * c + (t >> 2) : 16 * c + t;
                f[b] = __builtin_amdgcn_fmed3f(scr[kk * 32 + (n ^ W8_SWZ(kk))] * sc, -448.f, 448.f); }
            unsigned x = 0; x = __builtin_amdgcn_cvt_pk_fp8_f32(f[0], f[1], x, false); x = __builtin_amdgcn_cvt_pk_fp8_f32(f[2], f[3], x, true); o4[w] = x; }
        *(GAS v4u*)(W8 + ((size_t)(((n0 + n) >> 8) * 32 + kt) * 256 + ((n0 + n) & 255)) * 128 + 16 * c) = (v4u){o4[0], o4[1], o4[2], o4[3]}; }
#undef W8_SWZ
    LDS_WAIT(); asm volatile("" ::: "memory");
}
__device__ __forceinline__ void p0_prologue(Frame& F, const Args& args, const int parts = 7) {
    LAS float* scr = (LAS float*)(F.lds + RING_OFF + F.wave * 16384);
    const int gw = F.vcu * NWAVES + F.wave, NGW = F.G * NWAVES, lane0 = pg8::lane_id();
    constexpr int I_IN = (DM / 128) * (INW / 32), I_OUT = (DM / 128) * (DM / 32), I_UP = (DM / 64) * (FF / 32), I_DN = (FF / 64) * (DM / 32);
    constexpr int NITEMS = I_IN + I_OUT + I_UP + I_DN;
    if (parts & 1)
    for (int m = gw; m < MPAD; m += NGW) {
        unsigned char* xn = args.ws + WS_XN;
        if (m < TP) rms_row_to_f6((args.in[0]) + (size_t)m * DM, (args.in[4]), xn, m, lane0);
        else if (m < NTOK) rms_row_to_f6((args.in[1]) + (size_t)(m - TP) * DM, (args.in[4]), xn, m, lane0);
        else if (m < NTOK + NMETA) rms_row_to_f6((args.in[2]) + (size_t)(m - NTOK) * DM, (args.in[4]), xn, m, lane0);
        else {
#pragma unroll
            for (int j = 0; j < 16; ++j) *(GAS unsigned*)(xn + ((size_t)((m >> 8) * (DM / 128) + 2 * j + (lane0 >> 5)) * 256 + (m & 255)) * 128 + 4 * (lane0 & 31)) = 0u; }
    }
    for (int it = (parts & 2) ? gw : gw + ((I_IN + I_OUT - gw + NGW - 1) / NGW) * NGW; it < ((parts & 4) ? NITEMS : I_IN + I_OUT); it += NGW) {
        int r = it;
        if (r < I_IN) { p0_w6_item((args.in[5]), INW, args.ws + WS_WIN, scr, r, lane0); continue; } r -= I_IN;
        if (r < I_OUT) { p0_w8_item<true>((args.in[12]), DM, args.ws + WS_WOUT, scr, r, lane0); continue; } r -= I_OUT;
        if (r < I_UP) { p0_transpose_item((args.in[14]), DM, FF, ((bf16*)(args.ws + WS_WUP)), scr, r, lane0, WDROP_MLP, (args.in[13]), -1); continue; } r -= I_UP;
        p0_transpose_item((args.in[15]), FF, DM, ((bf16*)(args.ws + WS_WDN)), scr, r, lane0, WDROP_MLP, nullptr, -1);
    }
}
__device__ __forceinline__ int t5_tbl(int n) {
    return n < 8 ? n : (n < 12 ? 8 : (n < 16 ? 9 : (n < 23 ? 10 : (n < 32 ? 11 : (n < 46 ? 12 : (n < 64 ? 13 : (n < 91 ? 14 : 15)))))));
}

namespace att {
using bf16x8 = __attribute__((ext_vector_type(8))) short;
using s16x4  = __attribute__((ext_vector_type(4))) short;
using f32x16 = __attribute__((ext_vector_type(16))) float;
using u32x4  = __attribute__((ext_vector_type(4))) unsigned;
constexpr float LOG2E = 1.4426950408889634f, CS = 0.08838834764831845f * LOG2E, THRL = 11.0f, NEG = -1.0e30f;
constexpr int SHM_V = 16384, SHM_K = 16384;
constexpr int L_V = 0, L_K = 2 * SHM_V, L_WS = L_K + 2 * SHM_K, L_LUT = L_WS + 8 * 256;
constexpr int L_MV = 81920, L_MK = L_MV + SHM_V;
static_assert(L_LUT + 8192 <= L_MV && L_MK + SHM_K <= 131072, "attention LDS map");
#define KSWZ(row, colB) ((row) * 256 + ((colB) ^ (((row) & 7) << 4)))
#define SBAR() __builtin_amdgcn_sched_barrier(0)
__device__ __forceinline__ int crow(int r, int hi) { return (r & 3) + 8 * (r >> 2) + 4 * hi; }
__device__ __forceinline__ unsigned cvtpk(float lo, float hi) { unsigned r; asm volatile("v_cvt_pk_bf16_f32 %0, %1, %2" : "=v"(r) : "v"(lo), "v"(hi)); return r; }
__device__ __forceinline__ int v_st(int k, int c) { const int kk = (k & ~0xC) | ((k & 4) << 1) | ((k & 8) >> 1); return ((kk >> 3) * 4 + (c >> 5)) * 512 + ((kk & 7) * 32 + (c & 31)) * 2; }
__device__ __forceinline__ int v_rd_base(int lane) { return ((lane & 3) << 3) | (((lane >> 2) & 3) << 6) | (((lane >> 4) & 1) << 5) | (((lane >> 5) & 1) << 8); }
constexpr int v_rd_off(int d0, int ks, int half) { return d0 * 512 + ks * 4096 + half * 2048; }
template <int OFF> __device__ __forceinline__ s16x4 tr_read(int vb) {
  s16x4 r; asm volatile("ds_read_b64_tr_b16 %0, %1 offset:%2" : "=&v"(r) : "v"(vb), "i"(OFF) : "memory"); return r;
}
#define PKV(L, H) (bf16x8){L[0], L[1], L[2], L[3], H[0], H[1], H[2], H[3]}
template <int D0> __device__ __forceinline__ void pv_one(f32x16& od, int vb, bf16x8 pa0, bf16x8 pa1, bf16x8 pa2, bf16x8 pa3) {
  const s16x4 l0 = tr_read<v_rd_off(D0, 0, 0)>(vb), h0 = tr_read<v_rd_off(D0, 0, 1)>(vb), l1 = tr_read<v_rd_off(D0, 1, 0)>(vb), h1 = tr_read<v_rd_off(D0, 1, 1)>(vb);
  const s16x4 l2 = tr_read<v_rd_off(D0, 2, 0)>(vb), h2 = tr_read<v_rd_off(D0, 2, 1)>(vb), l3 = tr_read<v_rd_off(D0, 3, 0)>(vb), h3 = tr_read<v_rd_off(D0, 3, 1)>(vb);
  asm volatile("s_waitcnt lgkmcnt(0)" ::: "memory"); SBAR();
  od = __builtin_amdgcn_mfma_f32_32x32x16_bf16(pa0, PKV(l0, h0), od, 0, 0, 0);
  od = __builtin_amdgcn_mfma_f32_32x32x16_bf16(pa1, PKV(l1, h1), od, 0, 0, 0);
  od = __builtin_amdgcn_mfma_f32_32x32x16_bf16(pa2, PKV(l2, h2), od, 0, 0, 0);
  od = __builtin_amdgcn_mfma_f32_32x32x16_bf16(pa3, PKV(l3, h3), od, 0, 0, 0);
}
template <int D0> __device__ __forceinline__ void pv_one16(f32x16& od, int vb, bf16x8 pa0) {
  const s16x4 l0 = tr_read<v_rd_off(D0, 0, 0)>(vb), h0 = tr_read<v_rd_off(D0, 0, 1)>(vb);
  asm volatile("s_waitcnt lgkmcnt(0)" ::: "memory"); SBAR();
  od = __builtin_amdgcn_mfma_f32_32x32x16_bf16(pa0, PKV(l0, h0), od, 0, 0, 0);
}
#define PK4(P, BASE, OUT) do { unsigned a0 = cvtpk(P[BASE + 0], P[BASE + 1]), a1 = cvtpk(P[BASE + 2], P[BASE + 3]);   \
    unsigned b0 = cvtpk(P[BASE + 4], P[BASE + 5]), b1 = cvtpk(P[BASE + 6], P[BASE + 7]);                              \
    auto r0_ = __builtin_amdgcn_permlane32_swap(a0, b0, false, false); auto r1_ = __builtin_amdgcn_permlane32_swap(a1, b1, false, false); \
    u32x4 w_ = {r0_[0], r1_[0], r0_[1], r1_[1]}; OUT = *reinterpret_cast<bf16x8*>(&w_); } while (0)

template <int MODE>
__device__ __forceinline__ void tile_step(const LAS char* Kt, const int vb, const bf16x8 (&qr)[8], f32x16 (&o)[4], float& m_reg, float& l_reg,
                                          LAS float* al_l, const int r32, const int hi, const LAS float* lutp, const int ucs) {
  f32x16 p0 = {}, p1 = {};
#pragma unroll
  for (int d0 = 0; d0 < 8; ++d0) { const int cb = (d0 * 16 + hi * 8) * 2;
    const bf16x8 b0 = *reinterpret_cast<const LAS bf16x8*>(Kt + KSWZ(r32, cb));
    p0 = __builtin_amdgcn_mfma_f32_32x32x16_bf16(b0, qr[d0], p0, 0, 0, 0);
    if (MODE >= 2) { const bf16x8 b1 = *reinterpret_cast<const LAS bf16x8*>(Kt + KSWZ(32 + r32, cb)); p1 = __builtin_amdgcn_mfma_f32_32x32x16_bf16(b1, qr[d0], p1, 0, 0, 0); }
    if ((d0 & 3) == 3) SBAR(); }
#pragma unroll
  for (int r = 0; r < 16; ++r) { const int ki = (r & 3) + 8 * (r >> 2);
    if (MODE == 0) p0[r] = (r < 8) ? p0[r] * CS : NEG;
    if (MODE == 1) p0[r] = (r < 8) ? fmaf(p0[r], CS, lutp[ki]) : NEG;
    if (MODE == 2) { p0[r] = fmaf(p0[r], CS, lutp[ki]); p1[r] = fmaf(p1[r], CS, lutp[ki + 32]); }
    if (MODE == 3) { const float a = fmaf(p0[r], CS, lutp[ki]), b = fmaf(p1[r], CS, lutp[ki + 32]);
      p0[r] = ((unsigned)(ucs + ki) < 16u) ? a : NEG; p1[r] = ((unsigned)(ucs + ki + 32) < 16u) ? b : NEG; } }
  SBAR();
  float pmax = p0[0];
#pragma unroll
  for (int r = 1; r < 16; ++r) pmax = fmaxf(pmax, p0[r]);
  if (MODE >= 2) {
#pragma unroll
    for (int r = 0; r < 16; ++r) pmax = fmaxf(pmax, p1[r]); }
  { auto rr = __builtin_amdgcn_permlane32_swap(__float_as_uint(pmax), __float_as_uint(pmax), false, false); pmax = fmaxf(__uint_as_float(rr[0]), __uint_as_float(rr[1])); }
  float mn, alpha;
  if (__all(pmax - m_reg <= THRL)) { mn = m_reg; alpha = 1.f; }
  else { mn = fmaxf(m_reg, pmax); alpha = __builtin_amdgcn_exp2f(m_reg - mn); m_reg = mn; }
  float ps = 0.f;
#pragma unroll
  for (int r = 0; r < 16; ++r) { p0[r] = __builtin_amdgcn_exp2f(p0[r] - mn); ps += p0[r]; }
  if (MODE >= 2) {
#pragma unroll
    for (int r = 0; r < 16; ++r) { p1[r] = __builtin_amdgcn_exp2f(p1[r] - mn); ps += p1[r]; } }
  { auto rr = __builtin_amdgcn_permlane32_swap(__float_as_uint(ps), __float_as_uint(ps), false, false); ps = __uint_as_float(rr[0]) + __uint_as_float(rr[1]); }
  l_reg = l_reg * alpha + ps;
  if (__any(alpha < 1.f)) { if (hi == 0) al_l[r32] = alpha; asm volatile("s_waitcnt lgkmcnt(0)" ::: "memory");
#pragma unroll
    for (int r = 0; r < 16; ++r) { const float a = al_l[crow(r, hi)];
#pragma unroll
      for (int d = 0; d < 4; ++d) o[d][r] *= a; } }
  SBAR();
  bf16x8 pa0, pa1, pa2, pa3;
  PK4(p0, 0, pa0);
  if (MODE >= 2) { PK4(p0, 8, pa1); PK4(p1, 0, pa2); PK4(p1, 8, pa3);
    pv_one<0>(o[0], vb, pa0, pa1, pa2, pa3); pv_one<1>(o[1], vb, pa0, pa1, pa2, pa3); pv_one<2>(o[2], vb, pa0, pa1, pa2, pa3); pv_one<3>(o[3], vb, pa0, pa1, pa2, pa3); }
  else { pv_one16<0>(o[0], vb, pa0); pv_one16<1>(o[1], vb, pa0); pv_one16<2>(o[2], vb, pa0); pv_one16<3>(o[3], vb, pa0); }
}
__device__ __forceinline__ void store_o(const f32x16 (&o)[4], float l_reg, LAS float* li_l, unsigned char* ATT8  , int grow0, int ktile, int r32, int hi) {
  if (hi == 0) li_l[r32] = l_reg; asm volatile("s_waitcnt lgkmcnt(0)" ::: "memory");
#pragma unroll
  for (int r = 0; r < 16; ++r) {
    const float ia = __builtin_amdgcn_rcpf(li_l[crow(r, hi)]) * (float)(1 << F8_SH_A);
    const float x0 = __builtin_amdgcn_fmed3f(o[0][r] * ia, -448.f, 448.f), x1 = __builtin_amdgcn_fmed3f(o[1][r] * ia, -448.f, 448.f);
    const float x2 = __builtin_amdgcn_fmed3f(o[2][r] * ia, -448.f, 448.f), x3 = __builtin_amdgcn_fmed3f(o[3][r] * ia, -448.f, 448.f);
    unsigned w = 0; w = __builtin_amdgcn_cvt_pk_fp8_f32(x0, x1, w, false); w = __builtin_amdgcn_cvt_pk_fp8_f32(x2, x3, w, true);
    const int row = grow0 + crow(r, hi);
    *(GAS unsigned*)(ATT8 + ((size_t)((row >> 8) * 32 + ktile) * 256 + (row & 255)) * 128 + 4 * r32) = w; }
}
__device__ __forceinline__ void seq_of_row(int row0, int& s0, int& T) { if (row0 < TP) { s0 = 0; T = TP; } else { s0 = TP + (((row0 - TP) >> 11) << 11); T = TS; } }

__device__ __forceinline__ void dma_offsets(int wid, int lane, unsigned (&koff)[2], unsigned (&voff)[2]) {
#pragma unroll
  for (int j = 0; j < 2; ++j) { const int X = (wid * 2 + j) * 1024 + lane * 16;
    { const int row = X >> 8, chp = (X >> 4) & 15, ch = chp ^ (row & 7); koff[j] = (unsigned)(row * INW + ch * 8) * 2u; }
    { const int st = X >> 9, kk = (st >> 2) * 8 + ((X & 511) >> 6), k = (kk & ~0xC) | ((kk & 4) << 1) | ((kk & 8) >> 1), c = (st & 3) * 32 + ((X & 63) >> 1); voff[j] = (unsigned)(k * INW + c) * 2u; } }
}
#define ATT_DMA_AT(krow0, KO, VO) do { const char* gb_ = (const char*)(PROJ + (size_t)(krow0) * INW); \
    _Pragma("unroll") for (int j_ = 0; j_ < 2; ++j_) __builtin_amdgcn_global_load_lds((const unsigned*)(gb_ + kcol * 2 + koff[j_]), (LAS unsigned*)(L + (KO) + (wid * 2 + j_) * 1024), 16, 0, 0); \
    _Pragma("unroll") for (int j_ = 0; j_ < 2; ++j_) __builtin_amdgcn_global_load_lds((const unsigned*)(gb_ + vcol * 2 + voff[j_]), (LAS unsigned*)(L + (VO) + (wid * 2 + j_) * 1024), 16, 0, 0); } while (0)
#define ATT_DMA(krow0, B) ATT_DMA_AT(krow0, L_K + (B) * SHM_K, L_V + (B) * SHM_V)
#define ATT_SYNC() do { asm volatile("s_waitcnt vmcnt(0)" ::: "memory"); __syncthreads(); } while (0)

__device__ __forceinline__ void swa_phase(Frame& F, const Args& args) {
  const int wid = F.wave, lane = pg8::lane_id(), tid = wid * 64 + lane, r32 = lane & 31, hi = lane >> 5;
  LAS char* L = (LAS char*)F.lds + RING_OFF;
  LAS float* wsf = (LAS float*)(L + L_WS) + wid * 64; LAS float* li_l = wsf; LAS float* al_l = wsf + 32;
  LAS float* lut = (LAS float*)(L + L_LUT);
  const bf16* PROJ = (const bf16*)(args.ws + WS_PROJ); unsigned char* ATT = args.ws + WS_ATT;
  const float* t5 = args.in[3]; const float* sink = args.in[11];
  unsigned koff[2], voff[2]; dma_offsets(wid, lane, koff, voff);
  const int vb0 = (int)(unsigned)(size_t)(L + L_V) + v_rd_base(lane);
  const int g = wid >> 1, sub = wid & 1;
  constexpr int NU = (NTOK / 64) * 4;
  const int u_lo = (int)((long)F.vcu * NU / F.G), u_hi = (int)((long)(F.vcu + 1) * NU / F.G);
  int lut_kvh = -1;
  for (int u = u_lo; u < u_hi; ++u) {
    const int kvh = u / (NTOK / 64), blk = u % (NTOK / 64), row0 = blk * 64;
    int s0, T; seq_of_row(row0, s0, T);
    const int t0 = row0 - s0, hq = kvh * 4 + g;
    const int kcol = C_KSW + kvh * 128, vcol = C_VSW + kvh * 128;
    int tido = tid; asm volatile("" : "+v"(tido));
    const int r32o = tido & 31, hio = (tido >> 5) & 1;
    const bool newh = (kvh != lut_kvh);
    if (newh) { lut_kvh = kvh;
    for (int e = tido; e < 2048; e += 512) { const int gg = e >> 9, j = e & 511, hh = kvh * 4 + gg; float v = 0.f;
      if (j < 383) { const int rel = j - 191, n = rel < 0 ? -rel : rel; v = (n <= 128) ? t5[((rel > 0 ? 16 : 0) + t5_tbl(n)) * 16 + hh] * LOG2E : NEG; }
      else if (j >= 384 && j < 384 + 106) v = t5[t5_tbl(106 - (j - 384)) * 16 + hh] * LOG2E;
      lut[e] = v; } }
    const int tq = t0 + 32 * sub + r32o;
    bf16x8 qr[8];
    { const bf16* qp = PROJ + (size_t)(row0 + 32 * sub + r32o) * INW + C_QSW + hq * 128 + hio * 8;
#pragma unroll
      for (int d0 = 0; d0 < 8; ++d0) qr[d0] = *(const GAS bf16x8*)(qp + d0 * 16); }
    const int k_lo = t0 >= 128 ? 0 : (128 - t0) / 64, k_hi = min(4, (T + 64 - t0) / 64);
    f32x16 o[4] = {}; float m_reg = NEG, l_reg = 0.f;
    const int nw = k_hi - k_lo + 1;
    const int wrow0 = s0 + t0 - 128 + 64 * k_lo;
    const LAS float* lutw = lut + g * 512 + 64 * k_lo + 63 - 32 * sub - r32o + 4 * hio;
#define SWA_COMPUTE(j, B) tile_step<2>(L + L_K + (B) * SHM_K, vb0 + (B) * SHM_V, qr, o, m_reg, l_reg, al_l, r32, hi, lutw + 64 * (j), 0)
    if (newh) ATT_DMA_AT(META_ROW0, L_MK, L_MV);
    ATT_DMA(wrow0, 1); ATT_SYNC();
    if (nw > 1) ATT_DMA(wrow0 + 64, 0);
    tile_step<1>(L + L_MK, vb0 + L_MV, qr, o, m_reg, l_reg, al_l, r32, hi, lut + g * 512 + 384 + (90 - min(tq, 90)) + 4 * hio, 0);
    SWA_COMPUTE(0, 1); ATT_SYNC();
    for (int j = 1; j < nw; j += 2) {
      if (j + 1 < nw) ATT_DMA(wrow0 + 64 * (j + 1), 1);
      SWA_COMPUTE(j, 0); ATT_SYNC();
      if (j + 1 < nw) { if (j + 2 < nw) ATT_DMA(wrow0 + 64 * (j + 2), 0);
        SWA_COMPUTE(j + 1, 1); ATT_SYNC(); }
    }
#undef SWA_COMPUTE
    l_reg += __builtin_amdgcn_exp2f(sink[hq] * LOG2E - m_reg);
    { int tidp = tid; asm volatile("" : "+v"(tidp)); store_o(o, l_reg, li_l, ATT, row0 + 32 * sub, 16 + hq, tidp & 31, (tidp >> 5) & 1); }
  }
}
__device__ __forceinline__ void na_phase(Frame& F, const Args& args) {
  const int wid = F.wave, lane = pg8::lane_id(), tid = wid * 64 + lane, r32 = lane & 31, hi = lane >> 5;
  LAS char* L = (LAS char*)F.lds + RING_OFF;
  LAS float* wsf = (LAS float*)(L + L_WS) + wid * 64; LAS float* li_l = wsf; LAS float* al_l = wsf + 32;
  LAS float* lut = (LAS float*)(L + L_LUT);
  const bf16* PROJ = (const bf16*)(args.ws + WS_PROJ); unsigned char* ATT = args.ws + WS_ATT;
  const float* rpb = args.in[8];
  unsigned koff[2], voff[2]; dma_offsets(wid, lane, koff, voff);
  const int vb0 = (int)(unsigned)(size_t)(L + L_V) + v_rd_base(lane);
  constexpr int NU = (NTOK / 256) * 16;
  const int u_lo = (int)((long)F.vcu * NU / F.G), u_hi = (int)((long)(F.vcu + 1) * NU / F.G);
  int lut_h = -1;
  for (int u = u_lo; u < u_hi; ++u) {
    const int h = u / (NTOK / 256), blk = u % (NTOK / 256), row0 = blk * 256;
    int s0, T; seq_of_row(row0, s0, T);
    const int t0 = row0 - s0, r0 = t0 >> 6, rows = T >> 6;
    const int kcol = C_KNA + h * 128, vcol = C_VNA + h * 128;
    int tido = tid; asm volatile("" : "+v"(tido));
    const int r32o = tido & 31, hio = (tido >> 5) & 1;
    const bool newh = (h != lut_h);
    if (newh) { lut_h = h;
    for (int e = tido; e < 608; e += 512) { const int j = e - 64; float v = 0.f;
      if (j >= 0 && j < 480 && (j & 31) < 31) v = rpb[(h * 15 + (j >> 5)) * 31 + (j & 31)] * LOG2E;
      lut[e] = v; } }
    const int r = r0 + (wid >> 1), c = 32 * (wid & 1) + r32o;
    const int cs = min(max(c - 8, 0), 48), rs_w = min(max(r - 4, 0), rows - 8);
    const int kr_lo = min(max(r0 - 4, 0), rows - 8), kr_hi = min(max(r0 - 1, 0), rows - 8) + 7;
    bf16x8 qr[8];
    { const bf16* qp = PROJ + (size_t)(row0 + 32 * wid + r32o) * INW + C_QNA + h * 128 + hio * 8;
#pragma unroll
      for (int d0 = 0; d0 < 8; ++d0) qr[d0] = *(const GAS bf16x8*)(qp + d0 * 16); }
    f32x16 o[4] = {}; float m_reg = NEG, l_reg = 0.f;
    const int nw = kr_hi - kr_lo + 1;
    const int wrow0 = s0 + kr_lo * 64;
    const LAS float* lutw = lut + 64 + (kr_lo - r + 7) * 32 + 15 - c + 4 * hio;
    const int ucs = 4 * hio - cs, ja = rs_w - kr_lo;
#define NA_COMPUTE(j, B) do { if ((j) >= ja && (j) <= ja + 7) tile_step<3>(L + L_K + (B) * SHM_K, vb0 + (B) * SHM_V, qr, o, m_reg, l_reg, al_l, r32, hi, lutw + 32 * (j), ucs); } while (0)
    if (newh) ATT_DMA_AT(META_ROW0, L_MK, L_MV);
    ATT_DMA(wrow0, 1); ATT_SYNC();
    if (nw > 1) ATT_DMA(wrow0 + 64, 0);
    tile_step<0>(L + L_MK, vb0 + L_MV, qr, o, m_reg, l_reg, al_l, r32, hi, lut, 0);
    NA_COMPUTE(0, 1); ATT_SYNC();
    for (int j = 1; j < nw; j += 2) {
      if (j + 1 < nw) ATT_DMA(wrow0 + 64 * (j + 1), 1);
      NA_COMPUTE(j, 0); ATT_SYNC();
      if (j + 1 < nw) { if (j + 2 < nw) ATT_DMA(wrow0 + 64 * (j + 2), 0);
        NA_COMPUTE(j + 1, 1); ATT_SYNC(); }
    }
#undef NA_COMPUTE
    { int tidp = tid; asm volatile("" : "+v"(tidp)); store_o(o, l_reg, li_l, ATT, row0 + 32 * wid, h, tidp & 31, (tidp >> 5) & 1); }
  }
}
#undef ATT_DMA
#undef ATT_DMA_AT
#undef ATT_SYNC
#undef PK4
#undef PKV
#undef KSWZ
}

constexpr int N_PHASES = 4 + 2 * NCH;

__global__ void __launch_bounds__(NWAVES * 64, 2) fwd_kernel(Args args) {
    extern __shared__ __attribute__((aligned(16))) unsigned char lds[];
    Frame F;
    F.lds = (LAS unsigned char*)lds;
    F.MISC = (volatile LAS unsigned*)(F.lds + MISC_OFF);
    const int tid0 = threadIdx.x; F.wave = __builtin_amdgcn_readfirstlane(tid0 >> 6);
    F.G = gridDim.x; { const int bx = blockIdx.x; F.vcu = (F.G % 8 == 0) ? (bx % 8) * (F.G / 8) + bx / 8 : bx; }
    F.ctl = (gu32*)(args.ws + WS_CTL);
    for (int u = tid0; u < (LDS_BYTES - LDSCTL_OFF) / 4; u += NWAVES * 64) ((LAS unsigned*)(F.lds + LDSCTL_OFF))[u] = 0u;
    __syncthreads();
    XcdBarrier bar; bar.bar = (unsigned*)(F.ctl + CW_BAR); bar.x = 0; bar.st = nullptr; bar.w0 = 0;
    if (!MK_SPLIT) bar = xcd_barrier_post((unsigned*)(F.ctl + CW_BAR), F.MISC + 8);
    const int lo = args.ph_lo, hi = args.ph_hi;
#define IN(k) (lo <= (k) && (k) < hi)
#define SEAM(k) do { if (IN(k) && IN((k) + 1)) xcd_barrier(bar); } while (0)

    if (IN(0)) {
#pragma unroll 1
        for (int rep = 0; rep < args.rep_p0; ++rep) p0_prologue(F, args, rep == 0 ? 7 : P0X);
    } SEAM(0);
    if (IN(1)) {
        { LAS float* gl = (LAS float*)(F.lds + GL_OFF); const int t = F.wave * 64 + pg8::lane_id(); const int which = t >> 7;
          const float* gsrc = which == 0 ? args.in[6] : (which == 1 ? args.in[7] : (which == 2 ? args.in[9] : args.in[10]));
          gl[t] = gsrc[t & 127]; __syncthreads(); }
        pg8::Gemm g = pg8::gemm_tiled(((bf16*)(args.ws + WS_XN)), ((bf16*)(args.ws + WS_WIN)), MPAD, INW, DM / 2); pg8::StaticOrder S; S.init(MPAD, INW, F.G, (int)blockIdx.x);
        pg8::EpiProjNorm E{((bf16*)(args.ws + WS_PROJ)), INW, (LAS float*)(F.lds + XL_OFF), (const LAS float*)(F.lds + GL_OFF)};
#pragma unroll 1
        for (int rep = 0; rep < args.rep_inproj; ++rep) pg8::gemm_phase<pg8::EpiProjNorm, pg8::StaticOrder, true, true, 3>(F.lds + RING_OFF, g, S, E, F.wave);
    } SEAM(1);
    if (IN(2)) {
#pragma unroll 1
        for (int rep = 0; rep < args.li; ++rep) { att::swa_phase(F, args); att::na_phase(F, args); __syncthreads(); }
    } SEAM(2);
    if (IN(3)) {
        pg8::Gemm g = pg8::gemm_tiled(((bf16*)(args.ws + WS_ATT)), ((bf16*)(args.ws + WS_WOUT)), NTOK, DM, DM / 2); pg8::StaticOrder S; S.init(NTOK, DM, F.G, (int)blockIdx.x);
        pg8::EpiResStats E{(args.in[0]), (args.in[1]), TP / 256, (args.out), ((bf16*)(args.ws + WS_H2)), (float*)(args.ws + WS_CTL) + CW_SSQ, DM, 1};
#pragma unroll 1
        for (int rep = args.rep_out - 1; rep >= 0; --rep) { E.live = (rep == 0); pg8::gemm_phase<pg8::EpiResStats, pg8::StaticOrder, true, true, true>(F.lds + RING_OFF, g, S, E, F.wave); }
    } SEAM(3);
#pragma unroll 1
    for (int half = 0; half < NCH; ++half) {
        if (IN(4 + 2 * half)) {
            pg8::Gemm g = pg8::gemm_tiled(((bf16*)(args.ws + WS_H2)) + (size_t)half * MHALF * DM, ((bf16*)(args.ws + WS_WUP)), MHALF, FF, DM); pg8::StaticOrder S; S.init(MHALF, FF, F.G, (int)blockIdx.x);
            pg8::EpiBf16<1, true> E{((bf16*)(args.ws + WS_U)), FF, 0};
#pragma unroll 1
            for (int rep = 0; rep < (half == 0 ? args.rep_up : 1); ++rep) pg8::gemm_phase<pg8::EpiBf16<1, true>, pg8::StaticOrder, true, true>(F.lds + RING_OFF, g, S, E, F.wave);
        } SEAM(4 + 2 * half);
        if (IN(5 + 2 * half)) {
            float* o = (args.out) + (size_t)half * MHALF * DM;
            pg8::Gemm g = pg8::gemm_tiled(((bf16*)(args.ws + WS_U)), ((bf16*)(args.ws + WS_WDN)), MHALF, DM, FF); pg8::StaticOrder S; S.init(MHALF, DM, F.G, (int)blockIdx.x, (F.G == 256) ? DOWN_WGM : 8);
            pg8::EpiResF32 E{o, DM, (const float*)(args.ws + WS_CTL) + CW_SSQ + half * MHALF, 1, ((const bf16*)(args.ws + WS_H2)) + (size_t)half * MHALF * DM};
#pragma unroll 1
            for (int rep = (half == 0 ? args.pad : 1) - 1; rep >= 0; --rep) { E.live = (rep == 0); pg8::gemm_phase<pg8::EpiResF32, pg8::StaticOrder, true, true>(F.lds + RING_OFF, g, S, E, F.wave); }
        }
        if (half + 1 < NCH) SEAM(5 + 2 * half);
    }
#undef IN
#undef SEAM
}

extern "C" void kernel_launch(void* const* d_in, const int* in_sizes, int n_in, void* d_out, int out_size, void* d_ws, size_t ws_size, hipStream_t stream) {
    static int grid = 0;
    if (grid == 0) {
        if (n_in != 16 || in_sizes[0] != TP * DM || in_sizes[1] != NSB * TS * DM || out_size != NTOK * DM || ws_size < WS_END) {
            fprintf(stderr, "kernel_launch: shape mismatch n_in %d in0 %d in1 %d out %d ws %zu (need %zu)\n", n_in, n_in > 0 ? in_sizes[0] : -1, n_in > 1 ? in_sizes[1] : -1, out_size, ws_size, (size_t)WS_END); grid = -1; return; }
        int dev = 0, cus = 0, per_cu = 0;
        if (hipGetDevice(&dev) != hipSuccess || hipDeviceGetAttribute(&cus, hipDeviceAttributeMultiprocessorCount, dev) != hipSuccess) { grid = -1; return; }
        if (hipFuncSetAttribute((const void*)fwd_kernel, hipFuncAttributeMaxDynamicSharedMemorySize, LDS_BYTES) != hipSuccess) { fprintf(stderr, "kernel_launch: hipFuncSetAttribute failed\n"); grid = -1; return; }
        if (hipOccupancyMaxActiveBlocksPerMultiprocessor(&per_cu, (const void*)fwd_kernel, NWAVES * 64, LDS_BYTES) != hipSuccess || per_cu < 1)
            fprintf(stderr, "kernel_launch: occupancy query reports %d\n", per_cu);
        (void)hipGetLastError();
        grid = cus;
    }
    if (grid < 0) return;
    if (hipMemsetAsync((char*)d_ws + WS_CTL, 0, CTL_ZERO_BYTES, stream) != hipSuccess) return;
    Args a{};
    for (int i = 0; i < 16; ++i) a.in[i] = (const float*)d_in[i];
    a.out = (float*)d_out; a.ws = (unsigned char*)d_ws; a.rep_p0 = REP_P0; a.rep_inproj = REP_INPROJ; a.rep_up = REP_UP; a.rep_out = REP_OUT; a.pad = REP_DOWN;
#if MK_SPLIT
    for (int p = 0; p < N_PHASES; ++p) { a.ph_lo = p; a.ph_hi = p + 1; a.li = p; hipLaunchKernelGGL(fwd_kernel, dim3(grid), dim3(NWAVES * 64), LDS_BYTES, stream, a); }
#else
    a.ph_lo = 0; a.ph_hi = N_PHASES; a.li = ATT_REPS;
    hipLaunchKernelGGL(fwd_kernel, dim3(grid), dim3(NWAVES * 64), LDS_BYTES, stream, a);
#endif
    const hipError_t le = hipPeekAtLastError();
    if (le != hipSuccess) fprintf(stderr, "kernel_launch: launch failed: %s\n", hipGetErrorName(le));
}
```
